# Optimizing an MI355X kernel written in HIP

```python
import math
import jax, jax.numpy as jnp
from jax import lax
import numpy as np

D_MODEL = 1024
BATCH = 2
SEQ = 16384
DEPTH = 2

N_EVEN = (DEPTH + 1) // 2
N_ODD = DEPTH // 2

S5_WIDTH = D_MODEL // 2
S5_GROUP = 16
S5_GROUPS = S5_WIDTH // S5_GROUP
S5_STATE = 64
S5_DT_MIN = 1e-3
S5_DT_MAX = 1e-1
CONV_WIDTH = D_MODEL // 2
CONV_K = 31
MIX_IN = S5_WIDTH + 2 * CONV_WIDTH
MIX_WIDTH = S5_WIDTH + CONV_WIDTH

HEAD_DIM = 64
N_Q_HEADS = D_MODEL // HEAD_DIM
N_KV_HEADS = 2
Q_PER_KV = N_Q_HEADS // N_KV_HEADS
QKV_WIDTH = (N_Q_HEADS + 2 * N_KV_HEADS) * HEAD_DIM
WINDOW = 128
ROPE_THETA = 500000.0
ROPE_DIM = HEAD_DIM // 4

PEER_HEADS = 8
PEER_N_KEYS = 128
PEER_N_EXPERTS = PEER_N_KEYS * PEER_N_KEYS
PEER_QUERY_DIM = 256
PEER_HALF = PEER_QUERY_DIM // 2
PEER_TOPK = 16
PEER_TOKEN_BLOCK = 128

NORM_EPS = 1e-6

kernel_name = "hybrid_s5_conv_swa_peer"


def rmsnorm(x, g):
    xf = x.astype(jnp.float32)
    y = xf * lax.rsqrt(jnp.mean(xf * xf, axis=-1, keepdims=True) + NORM_EPS) * g.astype(jnp.float32)
    return y.astype(x.dtype)


def s5_mixer(u, lam_re, lam_im, log_step, b_re, b_im, c_re, c_im, d, w_glu):
    bsz, seq, _ = u.shape
    uf = u.astype(jnp.float32).reshape(bsz, seq, S5_GROUPS, S5_GROUP)
    lam = lax.complex(lam_re.astype(jnp.float32), lam_im.astype(jnp.float32))
    dt = jnp.exp(log_step.astype(jnp.float32))[:, None]
    a_bar = jnp.exp(lam * dt)
    b = lax.complex(b_re.astype(jnp.float32), b_im.astype(jnp.float32))
    b_bar = ((a_bar - 1.0) / lam)[..., None] * b
    bu = lax.complex(jnp.einsum('blgh,gph->blgp', uf, jnp.real(b_bar)),
                     jnp.einsum('blgh,gph->blgp', uf, jnp.imag(b_bar)))
    a_seq = jnp.broadcast_to(a_bar, (1, seq) + a_bar.shape)

    def combine(left, right):
        a_l, b_l = left
        a_r, b_r = right
        return a_r * a_l, a_r * b_l + b_r

    _, h = lax.associative_scan(combine, (a_seq, bu), axis=1)
    y = (jnp.einsum('blgp,ghp->blgh', jnp.real(h), c_re.astype(jnp.float32))
         - jnp.einsum('blgp,ghp->blgh', jnp.imag(h), c_im.astype(jnp.float32))
         + d.astype(jnp.float32) * uf)
    y = jax.nn.gelu(y, approximate=False).reshape(bsz, seq, S5_WIDTH)
    out = y * jax.nn.sigmoid(y @ w_glu.astype(jnp.float32))
    return out.astype(u.dtype)


def conv_module(z, dw_w, dw_b, ln_g, ln_b):
    val, gate = jnp.split(z, 2, axis=-1)
    v = val * jax.nn.sigmoid(gate)
    y = lax.conv_general_dilated(v, dw_w[:, None, :], window_strides=(1,),
                                 padding=[(CONV_K - 1, 0)],
                                 dimension_numbers=('NWC', 'WIO', 'NWC'),
                                 feature_group_count=CONV_WIDTH) + dw_b
    yf = y.astype(jnp.float32)
    mu = jnp.mean(yf, axis=-1, keepdims=True)
    var = jnp.mean(jnp.square(yf - mu), axis=-1, keepdims=True)
    yn = (yf - mu) * lax.rsqrt(var + NORM_EPS) * ln_g.astype(jnp.float32) + ln_b.astype(jnp.float32)
    return jax.nn.silu(yn).astype(z.dtype)


def partial_rope(t, pos):
    inv = jnp.power(ROPE_THETA, -jnp.arange(0, ROPE_DIM, 2, dtype=jnp.float32) / ROPE_DIM)
    ang = pos[:, None] * inv[None, :]
    cos = jnp.cos(ang)[None, :, None, :]
    sin = jnp.sin(ang)[None, :, None, :]
    tr = t[..., :ROPE_DIM].astype(jnp.float32)
    x1, x2 = tr[..., :ROPE_DIM // 2], tr[..., ROPE_DIM // 2:]
    rot = jnp.concatenate([x1 * cos - x2 * sin, x2 * cos + x1 * sin], axis=-1).astype(t.dtype)
    return jnp.concatenate([rot, t[..., ROPE_DIM:]], axis=-1)


def sliding_window_attention(h, w_qkv, b_qkv, sinks, w_o):
    bsz, seq, _ = h.shape
    qkv = h @ w_qkv + b_qkv
    q, k, v = jnp.split(qkv, [N_Q_HEADS * HEAD_DIM, (N_Q_HEADS + N_KV_HEADS) * HEAD_DIM], axis=-1)
    pos = jnp.arange(seq, dtype=jnp.float32)
    q = partial_rope(q.reshape(bsz, seq, N_Q_HEADS, HEAD_DIM), pos)
    k = partial_rope(k.reshape(bsz, seq, N_KV_HEADS, HEAD_DIM), pos)
    v = v.reshape(bsz, seq, N_KV_HEADS, HEAD_DIM)
    nb = seq // WINDOW
    q = q.reshape(bsz, nb, WINDOW, N_KV_HEADS, Q_PER_KV, HEAD_DIM)
    k = k.reshape(bsz, nb, WINDOW, N_KV_HEADS, HEAD_DIM)
    v = v.reshape(bsz, nb, WINDOW, N_KV_HEADS, HEAD_DIM)

    def with_prev(t):
        prev = jnp.pad(t[:, :-1], ((0, 0), (1, 0), (0, 0), (0, 0), (0, 0)))
        return jnp.concatenate([prev, t], axis=2)

    kb, vb = with_prev(k), with_prev(v)
    s = jnp.einsum('bnqkgd,bnskd->bnkgqs', q, kb,
                   preferred_element_type=jnp.float32) * (HEAD_DIM ** -0.5)
    qi = jnp.arange(WINDOW)[:, None]
    si = jnp.arange(2 * WINDOW)[None, :]
    diff = WINDOW + qi - si
    band = (diff >= 0) & (diff < WINDOW)
    has_prev = (jnp.arange(nb)[:, None, None] > 0) | (si[None] >= WINDOW)
    valid = band[None] & has_prev
    s = jnp.where(valid[None, :, None, None], s, -jnp.inf)
    sink = sinks.astype(jnp.float32).reshape(N_KV_HEADS, Q_PER_KV)[None, None, :, :, None, None]
    m = jnp.maximum(jnp.max(s, axis=-1, keepdims=True), sink)
    p = jnp.exp(s - m)
    denom = jnp.sum(p, axis=-1, keepdims=True) + jnp.exp(sink - m)
    probs = (p / denom).astype(vb.dtype)
    o = jnp.einsum('bnkgqs,bnskd->bnqkgd', probs, vb)
    o = o.reshape(bsz, seq, N_Q_HEADS * HEAD_DIM).astype(h.dtype)
    return o @ w_o


def peer(h, w_q, sub_keys, u_tab, v_tab):
    bsz, seq, dm = h.shape
    t = bsz * seq
    hf = h.reshape(t, dm)
    q = (hf @ w_q).reshape(t, PEER_HEADS, 2, PEER_HALF)
    scores = jnp.einsum('thcd,hckd->thck', q, sub_keys,
                        preferred_element_type=jnp.float32)
    top_s, top_i = lax.top_k(scores, PEER_TOPK)
    cand_s = top_s[:, :, 0, :, None] + top_s[:, :, 1, None, :]
    cand_i = top_i[:, :, 0, :, None] * PEER_N_KEYS + top_i[:, :, 1, None, :]
    best_s, best_c = lax.top_k(cand_s.reshape(t, PEER_HEADS, PEER_TOPK * PEER_TOPK), PEER_TOPK)
    ids = jnp.take_along_axis(cand_i.reshape(t, PEER_HEADS, PEER_TOPK * PEER_TOPK), best_c, axis=-1)
    gates = jax.nn.softmax(best_s, axis=-1)
    n_exp = PEER_HEADS * PEER_TOPK
    nblk = t // PEER_TOKEN_BLOCK

    def token_block(args):
        xb, ib, gb = args
        u = jnp.take(u_tab, ib, axis=0)
        a = jnp.einsum('cd,ced->ce', xb, u, preferred_element_type=jnp.float32)
        w = (jax.nn.gelu(a, approximate=False) * gb).astype(v_tab.dtype)
        v = jnp.take(v_tab, ib, axis=0)
        return jnp.einsum('ce,ced->cd', w, v).astype(h.dtype)

    out = lax.map(token_block, (hf.reshape(nblk, PEER_TOKEN_BLOCK, dm),
                                ids.reshape(nblk, PEER_TOKEN_BLOCK, n_exp),
                                gates.reshape(nblk, PEER_TOKEN_BLOCK, n_exp)))
    return out.reshape(bsz, seq, dm)


def setup_inputs(seed: int = 0) -> dict:
    key = jax.random.key(seed)
    ks = iter(jax.random.split(key, 40))
    f32 = jnp.float32

    def nrm(shape, scale):
        return jax.random.normal(next(ks), shape, f32) * scale

    x = nrm((BATCH, SEQ, D_MODEL), 1.0)
    norm_mix = 1.0 + nrm((DEPTH, D_MODEL), 0.02)
    norm_ffn = 1.0 + nrm((DEPTH, D_MODEL), 0.02)
    norm_final = 1.0 + nrm((D_MODEL,), 0.02)
    mix_w_in = nrm((N_EVEN, D_MODEL, MIX_IN), D_MODEL ** -0.5)
    s5_lambda_re = -0.5 + nrm((N_EVEN, S5_GROUPS, S5_STATE), 0.01)
    s5_lambda_im = jnp.pi * jnp.arange(S5_STATE, dtype=f32) + nrm((N_EVEN, S5_GROUPS, S5_STATE), 0.01)
    s5_log_step = math.log(S5_DT_MIN) + jax.random.uniform(next(ks), (N_EVEN, S5_GROUPS), f32) * (
        math.log(S5_DT_MAX) - math.log(S5_DT_MIN))
    s5_b_re = nrm((N_EVEN, S5_GROUPS, S5_STATE, S5_GROUP), (2.0 * S5_GROUP) ** -0.5)
    s5_b_im = nrm((N_EVEN, S5_GROUPS, S5_STATE, S5_GROUP), (2.0 * S5_GROUP) ** -0.5)
    s5_c_re = nrm((N_EVEN, S5_GROUPS, S5_GROUP, S5_STATE), 0.5)
    s5_c_im = nrm((N_EVEN, S5_GROUPS, S5_GROUP, S5_STATE), 0.5)
    s5_d = nrm((N_EVEN, S5_GROUPS, S5_GROUP), 1.0)
    s5_w_glu = nrm((N_EVEN, S5_WIDTH, S5_WIDTH), S5_WIDTH ** -0.5)
    conv_dw_w = nrm((N_EVEN, CONV_K, CONV_WIDTH), CONV_K ** -0.5)
    conv_dw_b = nrm((N_EVEN, CONV_WIDTH), 0.01)
    conv_ln_g = 1.0 + nrm((N_EVEN, CONV_WIDTH), 0.02)
    conv_ln_b = nrm((N_EVEN, CONV_WIDTH), 0.01)
    mix_w_out = nrm((N_EVEN, MIX_WIDTH, D_MODEL), MIX_WIDTH ** -0.5)
    attn_w_qkv = nrm((N_ODD, D_MODEL, QKV_WIDTH), D_MODEL ** -0.5)
    attn_b_qkv = nrm((N_ODD, QKV_WIDTH), 0.01)
    attn_sinks = nrm((N_ODD, N_Q_HEADS), 0.5)
    attn_w_o = nrm((N_ODD, N_Q_HEADS * HEAD_DIM, D_MODEL), (N_Q_HEADS * HEAD_DIM) ** -0.5)
    peer_w_q = nrm((DEPTH, D_MODEL, PEER_HEADS * PEER_QUERY_DIM), D_MODEL ** -0.5)
    peer_sub_keys = nrm((DEPTH, PEER_HEADS, 2, PEER_N_KEYS, PEER_HALF), PEER_HALF ** -0.5)
    peer_u = nrm((DEPTH, PEER_N_EXPERTS, D_MODEL), D_MODEL ** -0.5)
    peer_v = nrm((DEPTH, PEER_N_EXPERTS, D_MODEL), 0.3)
    return {
        'x': x, 'norm_mix': norm_mix, 'norm_ffn': norm_ffn, 'norm_final': norm_final,
        'mix_w_in': mix_w_in, 's5_lambda_re': s5_lambda_re, 's5_lambda_im': s5_lambda_im,
        's5_log_step': s5_log_step, 's5_b_re': s5_b_re, 's5_b_im': s5_b_im,
        's5_c_re': s5_c_re, 's5_c_im': s5_c_im, 's5_d': s5_d, 's5_w_glu': s5_w_glu,
        'conv_dw_w': conv_dw_w, 'conv_dw_b': conv_dw_b, 'conv_ln_g': conv_ln_g, 'conv_ln_b': conv_ln_b,
        'mix_w_out': mix_w_out, 'attn_w_qkv': attn_w_qkv, 'attn_b_qkv': attn_b_qkv,
        'attn_sinks': attn_sinks, 'attn_w_o': attn_w_o, 'peer_w_q': peer_w_q,
        'peer_sub_keys': peer_sub_keys, 'peer_u': peer_u, 'peer_v': peer_v,
    }


def reference(x, norm_mix, norm_ffn, norm_final, mix_w_in, s5_lambda_re, s5_lambda_im,
              s5_log_step, s5_b_re, s5_b_im, s5_c_re, s5_c_im, s5_d, s5_w_glu,
              conv_dw_w, conv_dw_b, conv_ln_g, conv_ln_b, mix_w_out, attn_w_qkv, attn_b_qkv,
              attn_sinks, attn_w_o, peer_w_q, peer_sub_keys, peer_u, peer_v):
    for layer in range(DEPTH):
        i = layer // 2
        h = rmsnorm(x, norm_mix[layer])
        if layer % 2 == 0:
            z = h @ mix_w_in[i]
            y_ssm = s5_mixer(z[..., :S5_WIDTH], s5_lambda_re[i], s5_lambda_im[i], s5_log_step[i],
                             s5_b_re[i], s5_b_im[i], s5_c_re[i], s5_c_im[i], s5_d[i], s5_w_glu[i])
            y_conv = conv_module(z[..., S5_WIDTH:], conv_dw_w[i], conv_dw_b[i], conv_ln_g[i], conv_ln_b[i])
            x = x + jnp.concatenate([y_ssm, y_conv], axis=-1) @ mix_w_out[i]
        else:
            x = x + sliding_window_attention(h, attn_w_qkv[i], attn_b_qkv[i], attn_sinks[i], attn_w_o[i])
        x = x + peer(rmsnorm(x, norm_ffn[layer]), peer_w_q[layer], peer_sub_keys[layer],
                     peer_u[layer], peer_v[layer])
    return rmsnorm(x, norm_final)
```

```cpp
#include <hip/hip_runtime.h>
#include <hip/hip_cooperative_groups.h>
#include <cstdio>
#include <cstdint>
namespace cg = cooperative_groups;

#define LAS __attribute__((address_space(3)))
#define GAS __attribute__((address_space(1)))
typedef unsigned short bf16;
typedef short bf16x8 __attribute__((ext_vector_type(8)));
typedef float f32x16 __attribute__((ext_vector_type(16)));
typedef float f32x4 __attribute__((ext_vector_type(4)));
typedef unsigned u32x4 __attribute__((ext_vector_type(4)));
typedef unsigned u32x2q __attribute__((ext_vector_type(2)));
typedef unsigned u32x2 __attribute__((ext_vector_type(2)));

constexpr int T = 32768, D = 1024, SEQ = 16384;
constexpr int NT = 512, NW = 8;
constexpr int TILE = 128, NTILES = T / TILE;
constexpr int TILES_PER_SEQ = SEQ / TILE;
constexpr float EPS = 1e-6f;
constexpr int LDS_BYTES = 147456;

constexpr size_t MiB = 1u << 20;
constexpr size_t WS_WIN = 0;
constexpr size_t WS_WIN8 = 27 * MiB;
constexpr size_t WS_WGLU = 3 * MiB;
constexpr size_t WS_WOUT = 4 * MiB;
constexpr size_t WS_WQKV = 6 * MiB;
constexpr size_t WS_WQKV8 = 29 * MiB;
constexpr size_t WS_WO = 9 * MiB;
constexpr size_t WS_WQ = 11 * MiB;
constexpr size_t WS_WQ8 = 160 * MiB - 4 * MiB;
constexpr size_t WS_ROPE = 19 * MiB;
constexpr size_t WS_S5 = 20 * MiB;
constexpr size_t WS_S5E = 21 * MiB;
constexpr size_t WS_WSC = 26 * MiB;
constexpr size_t WSC_WIN = 0, WSC_WQ = 1536, WSC_WQKV = 1536 + 4096, WSC_WGLU = 6912, WSC_WOUT = 7424, WSC_WO = 8448;
constexpr size_t WS_CTL = 31 * MiB;
constexpr size_t WS_PU = 32 * MiB;
constexpr size_t WS_PV = 64 * MiB;
constexpr size_t WS_SU = 96 * MiB;
constexpr size_t WS_SV = 96 * MiB + 131072;
constexpr size_t WS_XQ = 97 * MiB;
constexpr size_t WS_SX = 129 * MiB;
constexpr size_t WS_ACT = 160 * MiB;
constexpr size_t WS_Z = 224 * MiB;
constexpr size_t WS_PRIV = 320 * MiB;
constexpr size_t PRIV_BYTES = 384 * 1024;
constexpr size_t WS_IDS = 416 * MiB;
constexpr size_t WS_GATES = 432 * MiB;
constexpr size_t WS_QT = 448 * MiB;
constexpr size_t WS_GB = 464 * MiB;
constexpr size_t WS_END = 480 * MiB;

struct Params {
    const float* in[27];
    float* out;
    unsigned char* ws;
};
typedef GAS const float* gcfp; typedef GAS float* gfp; typedef GAS bf16* gbp; typedef GAS const bf16* gcbp; typedef GAS unsigned char* gucp; typedef GAS const unsigned char* gcucp;
struct KP {
    gcfp in[27];
    gfp out;
    gucp ws;
};

__device__ __forceinline__ unsigned f2bf(float f) { unsigned u = __builtin_bit_cast(unsigned, f); return (u + 0x7fffu + ((u >> 16) & 1u)) >> 16; }
__device__ __forceinline__ unsigned pk2(float lo, float hi) { return f2bf(lo) | (f2bf(hi) << 16); }
__device__ __forceinline__ float bflo(unsigned u) { return __builtin_bit_cast(float, u << 16); }
__device__ __forceinline__ float bfhi(unsigned u) { return __builtin_bit_cast(float, u & 0xffff0000u); }
__device__ __forceinline__ float bf2f(bf16 h) { return __builtin_bit_cast(float, (unsigned)h << 16); }
__device__ __forceinline__ int lane_id() { return __builtin_amdgcn_mbcnt_hi(~0u, __builtin_amdgcn_mbcnt_lo(~0u, 0u)); }
__device__ __forceinline__ float wave_sum(float v) {
#pragma unroll
    for (int o = 1; o < 64; o <<= 1) v += __shfl_xor(v, o);
    return v;
}

template <int CTRL> __device__ __forceinline__ float dppf(float x) { return __builtin_bit_cast(float, __builtin_amdgcn_mov_dpp(__builtin_bit_cast(int, x), CTRL, 0xf, 0xf, true)); }
__device__ __forceinline__ float wave_sum_dpp(float x) {
    x += dppf<0xB1>(x); x += dppf<0x4E>(x); x += dppf<0x141>(x); x += dppf<0x128>(x);
    auto s = __builtin_amdgcn_permlane16_swap(__float_as_uint(x), __float_as_uint(x), false, false);
    x = __uint_as_float(s[0]) + __uint_as_float(s[1]);
    auto t = __builtin_amdgcn_permlane32_swap(__float_as_uint(x), __float_as_uint(x), false, false);
    return __uint_as_float(t[0]) + __uint_as_float(t[1]);
}
__device__ __forceinline__ float wave_max_dpp(float x) {
    x = fmaxf(x, dppf<0xB1>(x)); x = fmaxf(x, dppf<0x4E>(x)); x = fmaxf(x, dppf<0x141>(x)); x = fmaxf(x, dppf<0x128>(x));
    auto s = __builtin_amdgcn_permlane16_swap(__float_as_uint(x), __float_as_uint(x), false, false);
    x = fmaxf(__uint_as_float(s[0]), __uint_as_float(s[1]));
    auto t = __builtin_amdgcn_permlane32_swap(__float_as_uint(x), __float_as_uint(x), false, false);
    return fmaxf(__uint_as_float(t[0]), __uint_as_float(t[1]));
}

__device__ __forceinline__ void transpose_item(gcfp  W, int K, int N, gbp  WT, LAS float* scr, int item, int lane) {
    const int nblk = N / 32, kb = item / nblk, nb = item % nblk, k0 = 64 * kb, n0 = 32 * nb;
#pragma unroll 8
    for (int i = 0; i < 32; ++i) { const int kk = 2 * i + (lane >> 5); scr[kk * 33 + (lane & 31)] = W[(size_t)(k0 + kk) * N + n0 + (lane & 31)]; }
    asm volatile("s_waitcnt lgkmcnt(0)" ::: "memory");
    const int c = lane & 7;
#pragma unroll
    for (int j = 0; j < 4; ++j) { const int n = (lane >> 3) + 8 * j; const LAS float* s = scr + (8 * c) * 33 + n;
        u32x4 o; o.x = pk2(s[0 * 33], s[1 * 33]); o.y = pk2(s[2 * 33], s[3 * 33]); o.z = pk2(s[4 * 33], s[5 * 33]); o.w = pk2(s[6 * 33], s[7 * 33]);
        *(GAS u32x4*)(WT + (size_t)(n0 + n) * K + k0 + 8 * c) = o; }
    asm volatile("s_waitcnt lgkmcnt(0)" ::: "memory");
}

__device__ __forceinline__ void convert_flat(gcfp  src, gbp  dst, size_t n, size_t gtid, size_t gthreads) {
    for (size_t i = gtid * 8; i < n; i += gthreads * 8) {
        const f32x4 a = *(GAS const f32x4*)(src + i), b = *(GAS const f32x4*)(src + i + 4);
        u32x4 o; o.x = pk2(a.x, a.y); o.y = pk2(a.z, a.w); o.z = pk2(b.x, b.y); o.w = pk2(b.z, b.w);
        *(GAS u32x4*)(dst + i) = o;
    }
}

__device__ void s5_constants(const KP& p, int gtid);
#define XB_TILE(p, tile) ((gbp)((p).ws + WS_Z + (size_t)(tile) * TILE * 1536 * 2))
constexpr int P0_FB = 128, P0_WB = 212;
constexpr int P0_R1 = (NTILES - P0_WB) * NW * 49, P0_R2 = P0_R1 + (P0_WB - P0_FB) * NW * 37;
__device__ void phase0(const KP& p, LAS unsigned char* lds, int tid, int lane, int wid) {
    gucp  ws = p.ws;
    const int gw = blockIdx.x * NW + wid, NGW = gridDim.x * NW;
    LAS float* scr = (LAS float*)(lds + wid * 16384);
    if (blockIdx.x < P0_FB) {
        const int kq = wid;
        const int fi = blockIdx.x, layer = fi >> 6, nb = fi & 63, hh = nb >> 3, cc = (nb >> 2) & 1, kblk = nb & 3, n0 = nb * 32;
        const int lr = lane & 31, lh = lane >> 5;
        gcfp Wq = p.in[23] + (size_t)layer * 1024 * 2048 + hh * 256 + cc * 128 + lh * 8;
        gcfp Kk = p.in[24] + ((size_t)((layer * 8 + hh) * 2 + cc) * 128 + kblk * 32 + lr) * 128 + lh * 8;
        gucp WT = ws + WS_WQ8 + (size_t)layer * 2048 * 1024; gfp SC = (gfp)(ws + WS_WSC) + WSC_WQ + layer * 2048;
        LAS float* pm = (LAS float*)(lds + 131072);
        bf16x8 kf[8];
#pragma unroll
        for (int ks = 0; ks < 8; ++ks) { const f32x4 a = *(GAS const f32x4*)(Kk + ks * 16), b = *(GAS const f32x4*)(Kk + ks * 16 + 4);
            u32x4 o; o.x = pk2(a.x, a.y); o.y = pk2(a.z, a.w); o.z = pk2(b.x, b.y); o.w = pk2(b.z, b.w); kf[ks] = __builtin_bit_cast(bf16x8, o); }
        f32x16 facc[4];
#pragma unroll
        for (int mf = 0; mf < 4; ++mf) {
#pragma unroll
            for (int i = 0; i < 16; ++i) facc[mf][i] = 0.f;
            gcfp wrow = Wq + (size_t)(128 * kq + mf * 32 + lr) * 2048;
#pragma unroll
            for (int k4 = 0; k4 < 8; k4 += 4) {
                f32x4 wa[4][2];
#pragma unroll
                for (int ks = 0; ks < 4; ++ks) { wa[ks][0] = *(GAS const f32x4*)(wrow + (k4 + ks) * 16); wa[ks][1] = *(GAS const f32x4*)(wrow + (k4 + ks) * 16 + 4); }
#pragma unroll
                for (int ks = 0; ks < 4; ++ks) { u32x4 o; o.x = pk2(wa[ks][0].x, wa[ks][0].y); o.y = pk2(wa[ks][0].z, wa[ks][0].w); o.z = pk2(wa[ks][1].x, wa[ks][1].y); o.w = pk2(wa[ks][1].z, wa[ks][1].w);
                    facc[mf] = __builtin_amdgcn_mfma_f32_32x32x16_bf16(__builtin_bit_cast(bf16x8, o), kf[k4 + ks], facc[mf], 0, 0, 0); }
            }
        }
        float m = 0.f;
#pragma unroll
        for (int mf = 0; mf < 4; ++mf)
#pragma unroll
            for (int i = 0; i < 16; ++i) m = fmaxf(m, fabsf(facc[mf][i]));
        m = wave_max_dpp(m);
        if (lane == 0) pm[wid] = m;
        __syncthreads();
        m = fmaxf(fmaxf(fmaxf(pm[0], pm[1]), fmaxf(pm[2], pm[3])), fmaxf(fmaxf(pm[4], pm[5]), fmaxf(pm[6], pm[7])));
        const float scale = fmaxf(m, 1e-30f) * (1.0f / 127.0f), rs = 1.0f / scale;
        if (kq == 0 && lane < 32) SC[n0 + lane] = scale;
#pragma unroll
        for (int kb2 = 0; kb2 < 2; ++kb2) {
#pragma unroll
            for (int f = 0; f < 2; ++f)
#pragma unroll
                for (int i = 0; i < 16; ++i) scr[(f * 32 + (i & 3) + 8 * (i >> 2) + 4 * lh) * 33 + lr] = facc[2 * kb2 + f][i];
            asm volatile("s_waitcnt lgkmcnt(0)" ::: "memory");
            const int n = lane >> 1, kh = (lane & 1) * 32; u32x4 o[2];
#pragma unroll
            for (int q = 0; q < 8; ++q) { unsigned w = 0;
#pragma unroll
                for (int e = 0; e < 4; ++e) { const int qv = (int)rintf(scr[(kh + 4 * q + e) * 33 + n] * rs); w |= (unsigned)(qv & 0xff) << (8 * e); }
                o[q >> 2][q & 3] = w; }
            gucp dst = WT + (size_t)(n0 + n) * 1024 + (2 * kq + kb2) * 64 + kh;
            *(GAS u32x4*)dst = o[0]; *(GAS u32x4*)(dst + 16) = o[1];
            asm volatile("s_waitcnt lgkmcnt(0)" ::: "memory");
        }
    } else if (blockIdx.x < P0_WB) {
        const int it = ((int)blockIdx.x - P0_FB) * 2 + (wid >> 2), kq = wid & 3;
        gcfp W; int N, n0, K = 1024; gucp WT; gfp SC;
        if (it < 48) { W = p.in[4]; N = 1536; n0 = it * 32; WT = ws + WS_WIN8; SC = (gfp)(ws + WS_WSC) + WSC_WIN; }
        else if (it < 88) { W = p.in[19]; N = 1280; n0 = (it - 48) * 32; WT = ws + WS_WQKV8; SC = (gfp)(ws + WS_WSC) + WSC_WQKV; }
        else if (it < 120) { W = p.in[18]; N = 1024; n0 = (it - 88) * 32; WT = ws + WS_WOUT; SC = (gfp)(ws + WS_WSC) + WSC_WOUT; }
        else if (it < 152) { W = p.in[22]; N = 1024; n0 = (it - 120) * 32; WT = ws + WS_WO; SC = (gfp)(ws + WS_WSC) + WSC_WO; }
        else { W = p.in[13]; N = 512; K = 512; n0 = (it - 152) * 32; WT = ws + WS_WGLU; SC = (gfp)(ws + WS_WSC) + WSC_WGLU; }
        const int kbq = K >> 8;
        LAS float* pm = (LAS float*)(lds + 131072);
        f32x4 w[4][8];
#pragma unroll
        for (int kb2 = 0; kb2 < 4; ++kb2) if (kb2 < kbq) {
#pragma unroll
            for (int i = 0; i < 8; ++i) w[kb2][i] = *(GAS const f32x4*)(W + (size_t)((kbq * kq + kb2) * 64 + 8 * i + (lane >> 3)) * N + n0 + 4 * (lane & 7));
        }
        f32x4 m4 = (f32x4){0.f, 0.f, 0.f, 0.f};
#pragma unroll
        for (int kb2 = 0; kb2 < 4; ++kb2) if (kb2 < kbq) {
#pragma unroll
            for (int i = 0; i < 8; ++i) { m4.x = fmaxf(m4.x, fabsf(w[kb2][i].x)); m4.y = fmaxf(m4.y, fabsf(w[kb2][i].y)); m4.z = fmaxf(m4.z, fabsf(w[kb2][i].z)); m4.w = fmaxf(m4.w, fabsf(w[kb2][i].w)); }
        }
#pragma unroll
        for (int sh = 8; sh < 64; sh <<= 1) { m4.x = fmaxf(m4.x, __shfl_xor(m4.x, sh)); m4.y = fmaxf(m4.y, __shfl_xor(m4.y, sh)); m4.z = fmaxf(m4.z, __shfl_xor(m4.z, sh)); m4.w = fmaxf(m4.w, __shfl_xor(m4.w, sh)); }
        if (lane < 8) { pm[wid * 32 + 4 * lane] = m4.x; pm[wid * 32 + 4 * lane + 1] = m4.y; pm[wid * 32 + 4 * lane + 2] = m4.z; pm[wid * 32 + 4 * lane + 3] = m4.w; }
        __syncthreads();
        float m;
        { const int w0 = wid & ~3, c = lane & 31; m = fmaxf(fmaxf(pm[w0 * 32 + c], pm[(w0 + 1) * 32 + c]), fmaxf(pm[(w0 + 2) * 32 + c], pm[(w0 + 3) * 32 + c])); }
        const float scale = fmaxf(m, 1e-30f) * (1.0f / 127.0f);
        if (kq == 0 && lane < 32) SC[n0 + lane] = scale;
        const float rs_own = 1.0f / scale;
        const float rs = __shfl(rs_own, lane >> 1);
#pragma unroll
        for (int kb2 = 0; kb2 < 4; ++kb2) if (kb2 < kbq) {
            const int kb = kbq * kq + kb2;
#pragma unroll
            for (int i = 0; i < 8; ++i) { LAS float* d = scr + (8 * i + (lane >> 3)) * 33 + 4 * (lane & 7); d[0] = w[kb2][i].x; d[1] = w[kb2][i].y; d[2] = w[kb2][i].z; d[3] = w[kb2][i].w; }
            asm volatile("s_waitcnt lgkmcnt(0)" ::: "memory");
            const int n = lane >> 1, kh = (lane & 1) * 32; u32x4 o[2];
#pragma unroll
            for (int q = 0; q < 8; ++q) { unsigned wq = 0;
#pragma unroll
                for (int e = 0; e < 4; ++e) { const int qv = (int)rintf(scr[(kh + 4 * q + e) * 33 + n] * rs); wq |= (unsigned)(qv & 0xff) << (8 * e); }
                o[q >> 2][q & 3] = wq; }
            gucp dst = WT + (size_t)(n0 + n) * K + kb * 64 + kh;
            *(GAS u32x4*)dst = o[0]; *(GAS u32x4*)(dst + 16) = o[1];
            asm volatile("s_waitcnt lgkmcnt(0)" ::: "memory");
        }
    }
    const size_t gtid = (size_t)blockIdx.x * NT + tid, gthreads = (size_t)gridDim.x * NT;
    s5_constants(p, (int)gtid);
    for (size_t idx = gtid; idx < (size_t)SEQ * 8; idx += gthreads) {
        const int pos = (int)(idx >> 3), i = (int)(idx & 7);
        const float inv = __builtin_powf(500000.0f, -(float)i * 0.125f);
        float sn, cn; sincosf((float)pos * inv, &sn, &cn);
        typedef float f32x2r __attribute__((ext_vector_type(2)));
        ((GAS f32x2r*)(ws + WS_ROPE))[idx] = (f32x2r){cn, sn};
    }
    const int grp = blockIdx.x < P0_FB ? 2 : blockIdx.x < P0_WB ? 1 : 0;
    const int gb0 = grp == 2 ? 0 : grp == 1 ? P0_FB : P0_WB, gnb = grp == 2 ? P0_FB : grp == 1 ? P0_WB - P0_FB : (int)gridDim.x - P0_WB;
    const int TNGW = gnb * NW, tgw = ((int)blockIdx.x - gb0) * NW + wid;
    const int rbeg = grp == 0 ? 0 : grp == 1 ? P0_R1 : P0_R2, rend = grp == 0 ? P0_R1 : grp == 1 ? P0_R2 : 2 * 2 * 16384;
#pragma unroll 1
    for (int row0 = rbeg + tgw; row0 < rend; row0 += 4 * TNGW) {
        f32x4 v[4][4]; float m[4];
#pragma unroll
        for (int i = 0; i < 4; ++i) { const int row = min(row0 + i * TNGW, rend - 1), isv = row >= 2 * 16384, rr = isv ? row - 2 * 16384 : row;
            gcfp srcr = (isv ? p.in[26] : p.in[25]) + (size_t)rr * 1024 + 16 * lane;
#pragma unroll
            for (int j = 0; j < 4; ++j) v[i][j] = *(GAS const f32x4*)(srcr + 4 * j); }
#pragma unroll
        for (int i = 0; i < 4; ++i) { m[i] = 0.f;
#pragma unroll
            for (int j = 0; j < 4; ++j) m[i] = fmaxf(m[i], fmaxf(fmaxf(fabsf(v[i][j].x), fabsf(v[i][j].y)), fmaxf(fabsf(v[i][j].z), fabsf(v[i][j].w)))); }
#pragma unroll
        for (int i = 0; i < 4; ++i) m[i] = wave_max_dpp(m[i]);
#pragma unroll
        for (int i = 0; i < 4; ++i) { const int row = row0 + i * TNGW; if (row >= rend) continue;
            const int isv = row >= 2 * 16384, rr = isv ? row - 2 * 16384 : row;
            const float scale = fmaxf(m[i], 1e-30f) * (1.0f / 127.0f), rs = 1.0f / scale;
            const int off = isv ? 128 : 0;
            u32x4 o4;
#pragma unroll
            for (int j = 0; j < 4; ++j) {
                const int q0 = (int)rintf(v[i][j].x * rs) + off, q1 = (int)rintf(v[i][j].y * rs) + off, q2 = (int)rintf(v[i][j].z * rs) + off, q3 = (int)rintf(v[i][j].w * rs) + off;
                o4[j] = (unsigned)(q0 & 0xff) | ((unsigned)(q1 & 0xff) << 8) | ((unsigned)(q2 & 0xff) << 16) | ((unsigned)(q3 & 0xff) << 24);
            }
            *(GAS u32x4*)(ws + (isv ? WS_PV : WS_PU) + (size_t)rr * 1024 + 16 * lane) = o4;
            if (lane == 0) ((gfp)(ws + (isv ? WS_SV : WS_SU)))[rr] = scale;
        }
    }
}


constexpr size_t S5_ABAR = 0, S5_A128 = 16384, S5_BBAR = 32768, S5_CMAT = 163840;
__device__ void s5_constants(const KP& p, int gtid) {
    if (gtid >= 2048) return;
    const int g = gtid >> 6, pp = gtid & 63;
    gucp  base = p.ws + WS_S5;
    const double lre = (double)p.in[5][gtid], lim = (double)p.in[6][gtid];
    const double dt = exp((double)p.in[7][g]);
    const double mag = exp(lre * dt), ar = mag * cos(lim * dt), ai = mag * sin(lim * dt);
    ((gfp)(base + S5_ABAR))[gtid * 2 + 0] = (float)ar; ((gfp)(base + S5_ABAR))[gtid * 2 + 1] = (float)ai;
    double pr = ar, pi = ai;
    for (int i = 0; i < 7; ++i) { const double nr = pr * pr - pi * pi, ni = 2.0 * pr * pi; pr = nr; pi = ni; }
    ((gfp)(base + S5_A128))[gtid * 2 + 0] = (float)pr; ((gfp)(base + S5_A128))[gtid * 2 + 1] = (float)pi;
    const double den = lre * lre + lim * lim, nr_ = ar - 1.0, ni_ = ai;
    const double cr = (nr_ * lre + ni_ * lim) / den, ci = (ni_ * lre - nr_ * lim) / den;
    gbp  bb = (gbp)(base + S5_BBAR);
    for (int h = 0; h < 16; ++h) {
        const double br = (double)p.in[8][(size_t)gtid * 16 + h], bi = (double)p.in[9][(size_t)gtid * 16 + h];
        bb[((g * 2 + 0) * 64 + pp) * 16 + h] = (bf16)f2bf((float)(cr * br - ci * bi));
        bb[((g * 2 + 1) * 64 + pp) * 16 + h] = (bf16)f2bf((float)(cr * bi + ci * br));
    }
    gbp  cm = (gbp)(base + S5_CMAT);
    for (int h = 0; h < 16; ++h) {
        cm[(g * 16 + h) * 128 + pp] = (bf16)f2bf(p.in[10][(size_t)(g * 16 + h) * 64 + pp]);
        cm[(g * 16 + h) * 128 + 64 + pp] = (bf16)f2bf(-p.in[11][(size_t)(g * 16 + h) * 64 + pp]);
    }
}

__device__ __forceinline__ void rmsnorm_row_bf16(gcfp  xrow, gcfp  g, gbp  orow, int lane) {
    f32x4 v[4]; float s = 0.f;
#pragma unroll
    for (int j = 0; j < 4; ++j) { v[j] = *(GAS const f32x4*)(xrow + 4 * lane + 256 * j); s += (v[j].x * v[j].x + v[j].y * v[j].y) + (v[j].z * v[j].z + v[j].w * v[j].w); }
    const float rstd = 1.0f / sqrtf(wave_sum(s) * (1.0f / D) + EPS);
#pragma unroll
    for (int j = 0; j < 4; ++j) { const f32x4 gg = *(GAS const f32x4*)(g + 4 * lane + 256 * j); const f32x4 o = v[j] * rstd * gg;
        u32x2 w; w.x = pk2(o.x, o.y); w.y = pk2(o.z, o.w); *(GAS u32x2*)(orow + 4 * lane + 256 * j) = w; }
}

template <int R>
__device__ __forceinline__ void rmsnorm_rows_q8(gcfp x0, gcfp g, gucp xq0, gfp sx0, int lane) {
    f32x4 v[R][4]; float s[R], m[R];
#pragma unroll
    for (int i = 0; i < R; ++i)
#pragma unroll
        for (int j = 0; j < 4; ++j) v[i][j] = *(GAS const f32x4*)(x0 + (size_t)i * 8 * D + 4 * lane + 256 * j);
    f32x4 gg[4];
#pragma unroll
    for (int j = 0; j < 4; ++j) gg[j] = *(GAS const f32x4*)(g + 4 * lane + 256 * j);
#pragma unroll
    for (int i = 0; i < R; ++i) { s[i] = 0.f;
#pragma unroll
        for (int j = 0; j < 4; ++j) s[i] += (v[i][j].x * v[i][j].x + v[i][j].y * v[i][j].y) + (v[i][j].z * v[i][j].z + v[i][j].w * v[i][j].w); }
#pragma unroll
    for (int i = 0; i < R; ++i) s[i] = wave_sum_dpp(s[i]);
#pragma unroll
    for (int i = 0; i < R; ++i) { const float rstd = 1.0f / sqrtf(s[i] * (1.0f / D) + EPS); m[i] = 0.f;
#pragma unroll
        for (int j = 0; j < 4; ++j) { v[i][j] = v[i][j] * rstd * gg[j];
            m[i] = fmaxf(m[i], fmaxf(fmaxf(fabsf(v[i][j].x), fabsf(v[i][j].y)), fmaxf(fabsf(v[i][j].z), fabsf(v[i][j].w)))); } }
#pragma unroll
    for (int i = 0; i < R; ++i) m[i] = wave_max_dpp(m[i]);
#pragma unroll
    for (int i = 0; i < R; ++i) {
        const float scale = fmaxf(m[i], 1e-30f) * (1.0f / 127.0f), rs = 1.0f / scale;
        GAS unsigned* xq = (GAS unsigned*)(xq0 + (size_t)i * 8 * 1024);
#pragma unroll
        for (int j = 0; j < 4; ++j) { const int q0 = (int)rintf(v[i][j].x * rs), q1 = (int)rintf(v[i][j].y * rs), q2 = (int)rintf(v[i][j].z * rs), q3 = (int)rintf(v[i][j].w * rs);
            xq[lane + 64 * j] = (unsigned)(q0 & 0xff) | ((unsigned)(q1 & 0xff) << 8) | ((unsigned)(q2 & 0xff) << 16) | ((unsigned)(q3 & 0xff) << 24); }
        if (lane == 0) sx0[i * 8] = scale;
    }
}
__device__ __forceinline__ void rmsnorm_tile_q8(gcfp xt, gcfp g, gucp xqt, gfp sxt, int wid, int lane) {
#pragma unroll 1
    for (int r = wid; r < TILE; r += 4 * NW) rmsnorm_rows_q8<4>(xt + (size_t)r * D, g, xqt + (size_t)r * 1024, sxt + r, lane);
}

template <int R>
__device__ __forceinline__ void rmsnorm_rows_q8_bf(gcbp x0, gcfp g, gucp xq0, gfp sx0, int lane) {
    f32x4 v[R][4]; float s[R], m[R];
#pragma unroll
    for (int i = 0; i < R; ++i)
#pragma unroll
        for (int j = 0; j < 4; ++j) { const u32x2q w = *(GAS const u32x2q*)(x0 + (size_t)i * 8 * D + 4 * lane + 256 * j);
            v[i][j] = (f32x4){__uint_as_float(w.x << 16), __uint_as_float(w.x & 0xffff0000u), __uint_as_float(w.y << 16), __uint_as_float(w.y & 0xffff0000u)}; }
    f32x4 gg[4];
#pragma unroll
    for (int j = 0; j < 4; ++j) gg[j] = *(GAS const f32x4*)(g + 4 * lane + 256 * j);
#pragma unroll
    for (int i = 0; i < R; ++i) { s[i] = 0.f;
#pragma unroll
        for (int j = 0; j < 4; ++j) s[i] += (v[i][j].x * v[i][j].x + v[i][j].y * v[i][j].y) + (v[i][j].z * v[i][j].z + v[i][j].w * v[i][j].w); }
#pragma unroll
    for (int i = 0; i < R; ++i) s[i] = wave_sum_dpp(s[i]);
#pragma unroll
    for (int i = 0; i < R; ++i) { const float rstd = 1.0f / sqrtf(s[i] * (1.0f / D) + EPS); m[i] = 0.f;
#pragma unroll
        for (int j = 0; j < 4; ++j) { v[i][j] = v[i][j] * rstd * gg[j];
            m[i] = fmaxf(m[i], fmaxf(fmaxf(fabsf(v[i][j].x), fabsf(v[i][j].y)), fmaxf(fabsf(v[i][j].z), fabsf(v[i][j].w)))); } }
#pragma unroll
    for (int i = 0; i < R; ++i) m[i] = wave_max_dpp(m[i]);
#pragma unroll
    for (int i = 0; i < R; ++i) {
        const float scale = fmaxf(m[i], 1e-30f) * (1.0f / 127.0f), rs = 1.0f / scale;
        GAS unsigned* xq = (GAS unsigned*)(xq0 + (size_t)i * 8 * 1024);
#pragma unroll
        for (int j = 0; j < 4; ++j) { const int q0 = (int)rintf(v[i][j].x * rs), q1 = (int)rintf(v[i][j].y * rs), q2 = (int)rintf(v[i][j].z * rs), q3 = (int)rintf(v[i][j].w * rs);
            xq[lane + 64 * j] = (unsigned)(q0 & 0xff) | ((unsigned)(q1 & 0xff) << 8) | ((unsigned)(q2 & 0xff) << 16) | ((unsigned)(q3 & 0xff) << 24); }
        if (lane == 0) sx0[i * 8] = scale;
    }
}
__device__ __forceinline__ void rmsnorm_tile_q8_bf(gcbp xt, gcfp g, gucp xqt, gfp sxt, int wid, int lane) {
#pragma unroll 1
    for (int r = wid; r < TILE; r += 4 * NW) rmsnorm_rows_q8_bf<4>(xt + (size_t)r * D, g, xqt + (size_t)r * 1024, sxt + r, lane);
}
template <int R, int K>
__device__ __forceinline__ void quant_rows_bf16(gcbp a0, int lda, gucp xq0, gfp sx0, int lane) {
    constexpr int C = K / 512;
    u32x4 v[R][C]; float m[R];
#pragma unroll
    for (int i = 0; i < R; ++i)
#pragma unroll
        for (int c = 0; c < C; ++c) v[i][c] = *(GAS const u32x4*)(a0 + (size_t)i * 8 * lda + 8 * lane + 512 * c);
#pragma unroll
    for (int i = 0; i < R; ++i) { m[i] = 0.f;
#pragma unroll
        for (int c = 0; c < C; ++c)
#pragma unroll
            for (int e = 0; e < 4; ++e) { const unsigned w = v[i][c][e]; m[i] = fmaxf(m[i], fmaxf(fabsf(__uint_as_float(w << 16)), fabsf(__uint_as_float(w & 0xffff0000u)))); } }
#pragma unroll
    for (int i = 0; i < R; ++i) m[i] = wave_max_dpp(m[i]);
#pragma unroll
    for (int i = 0; i < R; ++i) {
        const float scale = fmaxf(m[i], 1e-30f) * (1.0f / 127.0f), rs = 1.0f / scale;
#pragma unroll
        for (int c = 0; c < C; ++c) { u32x2q o;
#pragma unroll
            for (int h = 0; h < 2; ++h) { const unsigned w0 = v[i][c][2 * h], w1 = v[i][c][2 * h + 1];
                const int q0 = (int)rintf(__uint_as_float(w0 << 16) * rs), q1 = (int)rintf(__uint_as_float(w0 & 0xffff0000u) * rs), q2 = (int)rintf(__uint_as_float(w1 << 16) * rs), q3 = (int)rintf(__uint_as_float(w1 & 0xffff0000u) * rs);
                o[h] = (unsigned)(q0 & 0xff) | ((unsigned)(q1 & 0xff) << 8) | ((unsigned)(q2 & 0xff) << 16) | ((unsigned)(q3 & 0xff) << 24); }
            *(GAS u32x2q*)(xq0 + (size_t)i * 8 * 1024 + 8 * lane + 512 * c) = o; }
        if (lane == 0) sx0[i * 8] = scale;
    }
}
template <int K>
__device__ __forceinline__ void quant_tile_bf16(gcbp at, int lda, gucp xqt, gfp sxt, int wid, int lane) {
#pragma unroll 1
    for (int r = wid; r < TILE; r += 4 * NW) quant_rows_bf16<4, K>(at + (size_t)r * lda, lda, xqt + (size_t)r * 1024, sxt + r, lane);
}

constexpr int G_STAGE = 49152;
typedef int i32x4v __attribute__((ext_vector_type(4)));
typedef int i32x16 __attribute__((ext_vector_type(16)));
__device__ __forceinline__ void gemm_issue(LAS unsigned char* lds, int s, gcucp A, int lda, gcucp Bt, int ldb, int kt, int wid, int lane) {
    const int r8 = lane >> 3, c8 = lane & 7;
#pragma unroll
    for (int i = 0; i < 2; ++i) { const int pc = wid + 8 * i, row = 8 * pc + r8, c = c8 ^ ((row >> 1) & 7);
        __builtin_amdgcn_global_load_lds((GAS const unsigned*)(A + (size_t)row * lda + kt * 128 + c * 16), (LAS unsigned*)(lds + s * G_STAGE + pc * 1024), 16, 0, 0); }
#pragma unroll
    for (int i = 0; i < 4; ++i) { const int pc = wid + 8 * i, row = 8 * pc + r8, c = c8 ^ ((row >> 1) & 7);
        __builtin_amdgcn_global_load_lds((GAS const unsigned*)(Bt + (size_t)row * ldb + kt * 128 + c * 16), (LAS unsigned*)(lds + s * G_STAGE + 16384 + pc * 1024), 16, 0, 0); }
}
__device__ __forceinline__ void gemm_tile_bytes(LAS unsigned char* lds, gcucp A, int lda, gcucp Bt, int ldb, int Kbytes, f32x16 (&acc)[2][2], int wid, int lane) {
    const int wr = wid >> 2, wc = wid & 3, lr = lane & 31, lh = lane >> 5, nk = Kbytes / 128;
#pragma unroll
    for (int m = 0; m < 2; ++m)
#pragma unroll
        for (int n = 0; n < 2; ++n)
#pragma unroll
            for (int i = 0; i < 16; ++i) acc[m][n][i] = 0.f;
    __syncthreads();
    gemm_issue(lds, 0, A, lda, Bt, ldb, 0, wid, lane);
    for (int kt = 0; kt < nk; ++kt) {
        const int s = kt & 1;
        asm volatile("s_waitcnt vmcnt(0)" ::: "memory");
        __syncthreads();
        if (kt + 1 < nk) gemm_issue(lds, s ^ 1, A, lda, Bt, ldb, kt + 1, wid, lane);
        LAS unsigned char* sa = lds + s * G_STAGE; LAS unsigned char* sb = sa + 16384;
#pragma unroll
        for (int ks = 0; ks < 4; ++ks) {
            bf16x8 a[2], b[2];
#pragma unroll
            for (int m = 0; m < 2; ++m) { const int row = wr * 64 + m * 32 + lr, c = (2 * ks + lh) ^ ((row >> 1) & 7); a[m] = *(const LAS bf16x8*)(sa + row * 128 + c * 16); }
#pragma unroll
            for (int n = 0; n < 2; ++n) { const int row = wc * 64 + n * 32 + lr, c = (2 * ks + lh) ^ ((row >> 1) & 7); b[n] = *(const LAS bf16x8*)(sb + row * 128 + c * 16); }
#pragma unroll
            for (int m = 0; m < 2; ++m)
#pragma unroll
                for (int n = 0; n < 2; ++n) acc[m][n] = __builtin_amdgcn_mfma_f32_32x32x16_bf16(a[m], b[n], acc[m][n], 0, 0, 0);
        }
    }
}
__device__ __forceinline__ void gemm_tile_i8(LAS unsigned char* lds, gcucp A, int lda, gcucp Bt, int ldb, int Kbytes, i32x16 (&acc)[2][2], int wid, int lane) {
    const int wr = wid >> 2, wc = wid & 3, lr = lane & 31, lh = lane >> 5, nk = Kbytes / 128;
#pragma unroll
    for (int m = 0; m < 2; ++m)
#pragma unroll
        for (int n = 0; n < 2; ++n)
#pragma unroll
            for (int i = 0; i < 16; ++i) acc[m][n][i] = 0;
    __syncthreads();
    gemm_issue(lds, 0, A, lda, Bt, ldb, 0, wid, lane);
    if (nk > 1) gemm_issue(lds, 1, A, lda, Bt, ldb, 1, wid, lane);
#pragma unroll 1
    for (int kt = 0, s = 0; kt < nk; ++kt, s = (s == 2 ? 0 : s + 1)) {
        if (kt + 1 < nk) asm volatile("s_waitcnt vmcnt(6)" ::: "memory"); else asm volatile("s_waitcnt vmcnt(0)" ::: "memory");
        asm volatile("s_waitcnt lgkmcnt(0)" ::: "memory");
        __builtin_amdgcn_s_barrier();
        asm volatile("" ::: "memory");
        if (kt + 2 < nk) gemm_issue(lds, (s == 0 ? 2 : s - 1), A, lda, Bt, ldb, kt + 2, wid, lane);
        LAS unsigned char* sa = lds + s * G_STAGE; LAS unsigned char* sb = sa + 16384;
#pragma unroll
        for (int ks = 0; ks < 4; ++ks) {
            i32x4v a[2], b[2];
#pragma unroll
            for (int m = 0; m < 2; ++m) { const int row = wr * 64 + m * 32 + lr, c = (2 * ks + lh) ^ ((row >> 1) & 7); a[m] = *(const LAS i32x4v*)(sa + row * 128 + c * 16); }
#pragma unroll
            for (int n = 0; n < 2; ++n) { const int row = wc * 64 + n * 32 + lr, c = (2 * ks + lh) ^ ((row >> 1) & 7); b[n] = *(const LAS i32x4v*)(sb + row * 128 + c * 16); }
#pragma unroll
            for (int m = 0; m < 2; ++m)
#pragma unroll
                for (int n = 0; n < 2; ++n) acc[m][n] = __builtin_amdgcn_mfma_i32_32x32x32_i8(a[m], b[n], acc[m][n], 0, 0, 0);
        }
    }
}
__device__ __forceinline__ void gemm_scores_i8(LAS unsigned char* lds, gcucp A, int lda, gcucp Bt, int ldb, int Kbytes, i32x16 (&acc)[4], int wid, int lane) {
    const int c = wid >> 2, tg = wid & 3, lr = lane & 31, lh = lane >> 5, nk = Kbytes / 128;
#pragma unroll
    for (int m = 0; m < 4; ++m)
#pragma unroll
        for (int i = 0; i < 16; ++i) acc[m][i] = 0;
    __syncthreads();
    gemm_issue(lds, 0, A, lda, Bt, ldb, 0, wid, lane);
    if (nk > 1) gemm_issue(lds, 1, A, lda, Bt, ldb, 1, wid, lane);
#pragma unroll 1
    for (int kt = 0, s = 0; kt < nk; ++kt, s = (s == 2 ? 0 : s + 1)) {
        if (kt + 1 < nk) asm volatile("s_waitcnt vmcnt(6)" ::: "memory"); else asm volatile("s_waitcnt vmcnt(0)" ::: "memory");
        asm volatile("s_waitcnt lgkmcnt(0)" ::: "memory");
        __builtin_amdgcn_s_barrier();
        asm volatile("" ::: "memory");
        if (kt + 2 < nk) gemm_issue(lds, (s == 0 ? 2 : s - 1), A, lda, Bt, ldb, kt + 2, wid, lane);
        LAS unsigned char* sa = lds + s * G_STAGE; LAS unsigned char* sb = sa + 16384;
#pragma unroll
        for (int ks = 0; ks < 4; ++ks) {
            i32x4v w[4], t;
            { const int row = tg * 32 + lr, ch = (2 * ks + lh) ^ ((row >> 1) & 7); t = *(const LAS i32x4v*)(sa + row * 128 + ch * 16); }
#pragma unroll
            for (int m = 0; m < 4; ++m) { const int row = c * 128 + m * 32 + lr, ch = (2 * ks + lh) ^ ((row >> 1) & 7); w[m] = *(const LAS i32x4v*)(sb + row * 128 + ch * 16); }
#pragma unroll
            for (int m = 0; m < 4; ++m) acc[m] = __builtin_amdgcn_mfma_i32_32x32x32_i8(w[m], t, acc[m], 0, 0, 0);
        }
    }
}
__device__ __forceinline__ void gemm_tile(LAS unsigned char* lds, gcbp A, int lda, gcbp Bt, int ldb, int K, f32x16 (&acc)[2][2], int wid, int lane) {
    gemm_tile_bytes(lds, (gcucp)A, lda * 2, (gcucp)Bt, ldb * 2, K * 2, acc, wid, lane);
}
#define OPAQUE_S(x) asm volatile("" : "+s"(x))
#define OPAQUE_V(x) asm volatile("" : "+v"(x))
template <class P> __device__ __forceinline__ P launder(P p) { asm volatile("" : "+v"(p)); return p; }
#define GEMM_RB(wid, lane) (((wid) >> 2) * 64 + 4 * ((lane) >> 5))
#define GEMM_CB(wid, lane) (((wid) & 3) * 64 + ((lane) & 31))
#define FR_ROW(i) (((i) & 3) + 8 * ((i) >> 2))
struct EpiSc { f32x4 rs[2][4]; float cs[2]; };
__device__ __forceinline__ void load_episc(EpiSc& e, gcfp sx_tile, gcfp sw_cols, int wid, int lane) {
    gcfp s = sx_tile + GEMM_RB(wid, lane);
#pragma unroll
    for (int m = 0; m < 2; ++m)
#pragma unroll
        for (int q = 0; q < 4; ++q) e.rs[m][q] = *(GAS const f32x4*)(s + 32 * m + 8 * q);
#pragma unroll
    for (int n = 0; n < 2; ++n) e.cs[n] = sw_cols[GEMM_CB(wid, lane) + 32 * n];
}
#define EPI_SCALE(e, i) ((e).cs[_n] * (e).rs[_m][(i) >> 2][(i) & 3])
#define GEMM_FOR_FRAGS_I(acc, CODE) do { \
    _Pragma("unroll") for (int _m = 0; _m < 2; ++_m) _Pragma("unroll") for (int _n = 0; _n < 2; ++_n) { \
        const int fo_r = _m * 32, fo_c = _n * 32; const i32x16 fr = acc[_m][_n]; CODE \
        asm volatile("" ::: "memory"); } } while (0)
#define GEMM_FOR_FRAGS(acc, CODE) do { \
    _Pragma("unroll") for (int _m = 0; _m < 2; ++_m) _Pragma("unroll") for (int _n = 0; _n < 2; ++_n) { \
        const int fo_r = _m * 32, fo_c = _n * 32; const f32x16 fr = acc[_m][_n]; CODE \
        asm volatile("" ::: "memory"); } } while (0)

__device__ __forceinline__ float gelu_exact(float v) { return 0.5f * v * (1.0f + erff(v * 0.70710678118654752f)); }

__device__ __forceinline__ float gelu_fast(float v) {
    const float av = fabsf(v), t = __builtin_amdgcn_rcpf(av * 0.2316418882f + 1.0f);
    float q = t * 0.5307027145f + (-0.7265760135f); q = q * t + 0.7107068705f; q = q * t + (-0.142248368f); q = q * t + 0.127414796f; q = q * t;
    const float e = __builtin_amdgcn_exp2f((v * v) * (-0.72134752044f));
    const float m = v * (q * e);
    return v < 0.f ? m : v - m;
}
__device__ __forceinline__ unsigned cvt_pk_bf16(float lo, float hi) { unsigned r; asm volatile("v_cvt_pk_bf16_f32 %0, %1, %2" : "=v"(r) : "v"(lo), "v"(hi)); return r; }
__device__ __forceinline__ float xchg32(float x, int lh) {
    auto s = __builtin_amdgcn_permlane32_swap(__float_as_uint(x), __float_as_uint(x), false, false);
    return __uint_as_float(lh ? s[0] : s[1]);
}
struct CPow { float r[4], i[4]; };
__device__ __forceinline__ CPow cpowers(float ar, float ai) {
    CPow c; c.r[0] = ar; c.i[0] = ai;
    c.r[1] = ar * ar - ai * ai; c.i[1] = 2.f * ar * ai;
    c.r[2] = c.r[1] * ar - c.i[1] * ai; c.i[2] = c.r[1] * ai + c.i[1] * ar;
    c.r[3] = c.r[1] * c.r[1] - c.i[1] * c.i[1]; c.i[3] = 2.f * c.r[1] * c.i[1];
    return c;
}
__device__ __forceinline__ void s5_scan32(f32x16& re, f32x16& im, const CPow& A, float& sr, float& si, int lh) {
    const float ar = A.r[0], ai = A.i[0];
#pragma unroll
    for (int k = 0; k < 4; ++k) {
        if (lh == 0) {
#pragma unroll
            for (int j = 0; j < 4; ++j) { const float nr = ar * sr - ai * si + re[4 * k + j], ni = ar * si + ai * sr + im[4 * k + j]; sr = nr; si = ni; re[4 * k + j] = nr; im[4 * k + j] = ni; }
        }
        float tr = __shfl_xor(sr, 32), ti = __shfl_xor(si, 32);
        if (lh == 1) { sr = tr; si = ti;
#pragma unroll
            for (int j = 0; j < 4; ++j) { const float nr = ar * sr - ai * si + re[4 * k + j], ni = ar * si + ai * sr + im[4 * k + j]; sr = nr; si = ni; re[4 * k + j] = nr; im[4 * k + j] = ni; }
        }
        tr = __shfl_xor(sr, 32); ti = __shfl_xor(si, 32);
        if (lh == 0) { sr = tr; si = ti; }
    }
}

template <bool FINAL>
__device__ void s5_tile(const KP& p, LAS unsigned char* lds, int tile, int wid, int lane) {
    OPAQUE_S(tile); OPAQUE_V(lane);
    gcucp  cst = p.ws + WS_S5;
    gcbp  Z = (gcbp)(p.ws + WS_Z) + (size_t)tile * TILE * 1536;
    gfp  E = (gfp)(p.ws + WS_S5E);
    gbp  YS = (gbp)(p.ws + WS_PRIV + (size_t)tile * PRIV_BYTES + 262144);
    const int lr = lane & 31, lh = lane >> 5;
    LAS unsigned char* hl = lds + wid * 8704;
    typedef float f32x2 __attribute__((ext_vector_type(2)));
    float i0r[4], i0i[4], i1r[4], i1i[4];
#pragma unroll
    for (int gi = 0; gi < 4; ++gi) { i0r[gi] = 0.f; i0i[gi] = 0.f; i1r[gi] = 0.f; i1i[gi] = 0.f; }
    if (FINAL) {
        const int tl = tile % TILES_PER_SEQ, tb = tile - tl, m = tl >> 1;
        const int jb = lh ? m : 0, cnt = lh ? tl - m : m, cmax = tl - m;
        float qr[4][2], qi[4][2];
#pragma unroll
        for (int gi = 0; gi < 4; ++gi) { gcfp a128 = (gcfp)(cst + S5_A128) + (size_t)(wid * 4 + gi) * 128;
            qr[gi][0] = a128[lr * 2]; qi[gi][0] = a128[lr * 2 + 1]; qr[gi][1] = a128[(32 + lr) * 2]; qi[gi][1] = a128[(32 + lr) * 2 + 1]; }
#pragma unroll 1
        for (int j0 = 0; j0 < cmax; j0 += 4) {
            f32x2 e0[4][4], e1[4][4];
#pragma unroll
            for (int jj = 0; jj < 4; ++jj) { const int j = jb + min(j0 + jj, max(cnt - 1, 0));
#pragma unroll
                for (int gi = 0; gi < 4; ++gi) { gcfp e = E + ((size_t)(tb + j) * 32 + wid * 4 + gi) * 128;
                    e0[jj][gi] = *(GAS const f32x2*)(e + lr * 2); e1[jj][gi] = *(GAS const f32x2*)(e + (32 + lr) * 2); } }
#pragma unroll
            for (int jj = 0; jj < 4; ++jj) if (j0 + jj < cnt) {
#pragma unroll
                for (int gi = 0; gi < 4; ++gi) {
                    float nr = qr[gi][0] * i0r[gi] - qi[gi][0] * i0i[gi] + e0[jj][gi].x, ni = qr[gi][0] * i0i[gi] + qi[gi][0] * i0r[gi] + e0[jj][gi].y; i0r[gi] = nr; i0i[gi] = ni;
                    nr = qr[gi][1] * i1r[gi] - qi[gi][1] * i1i[gi] + e1[jj][gi].x; ni = qr[gi][1] * i1i[gi] + qi[gi][1] * i1r[gi] + e1[jj][gi].y; i1r[gi] = nr; i1i[gi] = ni;
                }
            }
        }
#pragma unroll
        for (int gi = 0; gi < 4; ++gi) {
#pragma unroll
            for (int c = 0; c < 2; ++c) {
                float hr = c ? i1r[gi] : i0r[gi], hi = c ? i1i[gi] : i0i[gi];
                float br = qr[gi][c], bi = qi[gi][c], pr = 1.f, pi = 0.f;
                for (int n = tl - m; n > 0; n >>= 1) { if (n & 1) { const float t = pr * br - pi * bi; pi = pr * bi + pi * br; pr = t; } const float t2 = br * br - bi * bi; bi = 2.f * br * bi; br = t2; }
                const float orr = xchg32(hr, lh), oi = xchg32(hi, lh);
                const float fr = pr * hr - pi * hi + orr, fi = pr * hi + pi * hr + oi;
                if (c) { i1r[gi] = fr; i1i[gi] = fi; } else { i0r[gi] = fr; i0i[gi] = fi; }
            }
        }
    }
#pragma unroll
    for (int gi = 0; gi < 4; ++gi) {
        const int g = wid * 4 + gi;
        bf16x8 bfr[4];
#pragma unroll
        for (int n = 0; n < 4; ++n) bfr[n] = *(GAS const bf16x8*)((gcbp)(cst + S5_BBAR) + ((g * 2 + (n >> 1)) * 64 + (n & 1) * 32 + lr) * 16 + lh * 8);
        gcfp  ab = (gcfp)(cst + S5_ABAR) + (size_t)g * 128;
        const CPow A0 = cpowers(ab[lr * 2], ab[lr * 2 + 1]), A1 = cpowers(ab[(32 + lr) * 2], ab[(32 + lr) * 2 + 1]);
        float s0r = i0r[gi], s0i = i0i[gi], s1r = i1r[gi], s1i = i1i[gi];
        bf16x8 cfr[4]; float dv = 0.f;
        if (FINAL) {
#pragma unroll
            for (int ks = 0; ks < 4; ++ks) cfr[ks] = *(GAS const bf16x8*)((gcbp)(cst + S5_CMAT) + (g * 16 + (lane & 15)) * 128 + ks * 32 + 8 * (lane >> 4));
            dv = p.in[12][g * 16 + (lane & 15)];
        }
        bf16x8 afr = *(GAS const bf16x8*)(Z + (size_t)lr * 1536 + g * 16 + lh * 8);
#pragma unroll 1
        for (int mf = 0; mf < 4; ++mf) {
            const bf16x8 acur = afr;
            if (mf < 3) afr = *(GAS const bf16x8*)(Z + (size_t)((mf + 1) * 32 + lr) * 1536 + g * 16 + lh * 8);
            bf16 uu[2][4];
            if (FINAL) {
#pragma unroll
                for (int mr = 0; mr < 2; ++mr)
#pragma unroll
                    for (int i = 0; i < 4; ++i) uu[mr][i] = Z[(size_t)(mf * 32 + mr * 16 + (lane >> 4) * 4 + i) * 1536 + g * 16 + (lane & 15)];
            }
            f32x16 acc[4];
#pragma unroll
            for (int n = 0; n < 4; ++n) {
#pragma unroll
                for (int i = 0; i < 16; ++i) acc[n][i] = 0.f;
                acc[n] = __builtin_amdgcn_mfma_f32_32x32x16_bf16(acur, bfr[n], acc[n], 0, 0, 0);
            }
            s5_scan32(acc[0], acc[2], A0, s0r, s0i, lh);
            s5_scan32(acc[1], acc[3], A1, s1r, s1i, lh);
            if (FINAL) {
#pragma unroll
                for (int n = 0; n < 4; ++n)
#pragma unroll
                    for (int i = 0; i < 16; i += 2) { const int t = (i & 3) + 8 * (i >> 2) + 4 * lh, k = (n >> 1) * 64 + (n & 1) * 32 + lr;
                        const unsigned pk = cvt_pk_bf16(acc[n][i], acc[n][i + 1]);
                        *(LAS bf16*)(hl + t * 272 + k * 2) = (bf16)(pk & 0xffffu); *(LAS bf16*)(hl + (t + 1) * 272 + k * 2) = (bf16)(pk >> 16); }
#pragma unroll
                for (int mr = 0; mr < 2; ++mr) {
                    f32x4 y4 = {0.f, 0.f, 0.f, 0.f};
#pragma unroll
                    for (int ks = 0; ks < 4; ++ks) { const bf16x8 ha = *(const LAS bf16x8*)(hl + (mr * 16 + (lane & 15)) * 272 + (ks * 32 + 8 * (lane >> 4)) * 2);
                        y4 = __builtin_amdgcn_mfma_f32_16x16x32_bf16(ha, cfr[ks], y4, 0, 0, 0); }
#pragma unroll
                    for (int i = 0; i < 4; i += 2) { const int t = mf * 32 + mr * 16 + (lane >> 4) * 4 + i, ch = g * 16 + (lane & 15);
                        const unsigned pk = cvt_pk_bf16(gelu_fast(y4[i] + dv * bf2f(uu[mr][i])), gelu_fast(y4[i + 1] + dv * bf2f(uu[mr][i + 1])));
                        YS[(size_t)t * 512 + ch] = (bf16)(pk & 0xffffu); YS[(size_t)(t + 1) * 512 + ch] = (bf16)(pk >> 16); }
                }
            }
        }
        if (!FINAL && lh == 0) {
            gfp  e = E + ((size_t)tile * 32 + g) * 128;
            e[lr * 2] = s0r; e[lr * 2 + 1] = s0i; e[(32 + lr) * 2] = s1r; e[(32 + lr) * 2 + 1] = s1i;
        }
    }
}

__device__ void conv_tile(const KP& p, LAS unsigned char* lds, int tile, int, int wid, int) {
    int lane = lane_id(); int tid = wid * 64 + lane; (void)tid;
    OPAQUE_S(tile); OPAQUE_V(lane); OPAQUE_V(tid);
    gcbp  Zall = (gcbp)(p.ws + WS_Z);
    gfp  YC = (gfp)(p.ws + WS_PRIV + (size_t)tile * PRIV_BYTES);
    gbp  ACT = (gbp)(p.ws + WS_ACT) + (size_t)tile * TILE * 1024;
    LAS float* vt = (LAS float*)lds;
    const bool first = (tile % TILES_PER_SEQ) == 0;
    const long row0 = (long)tile * TILE - 30;
    for (int cc = 0; cc < 4; ++cc) {
        __syncthreads();
        for (int idx = tid; idx < 158 * 16; idx += NT) {
            const int j = idx >> 4, q = idx & 15;
            f32x4 o0 = {0.f, 0.f, 0.f, 0.f}, o1 = {0.f, 0.f, 0.f, 0.f};
            if (!(first && j < 30)) {
                gcbp  zr = Zall + (size_t)(row0 + j) * 1536 + 128 * cc + 8 * q;
                const u32x4 va = *(GAS const u32x4*)(zr + 512), ga = *(GAS const u32x4*)(zr + 1024);
                float v[8], gt[8];
                v[0] = bflo(va.x); v[1] = bfhi(va.x); v[2] = bflo(va.y); v[3] = bfhi(va.y); v[4] = bflo(va.z); v[5] = bfhi(va.z); v[6] = bflo(va.w); v[7] = bfhi(va.w);
                gt[0] = bflo(ga.x); gt[1] = bfhi(ga.x); gt[2] = bflo(ga.y); gt[3] = bfhi(ga.y); gt[4] = bflo(ga.z); gt[5] = bfhi(ga.z); gt[6] = bflo(ga.w); gt[7] = bfhi(ga.w);
#pragma unroll
                for (int e = 0; e < 8; ++e) v[e] = v[e] / (1.0f + __expf(-gt[e]));
                o0 = (f32x4){v[0], v[1], v[2], v[3]}; o1 = (f32x4){v[4], v[5], v[6], v[7]};
            }
            *(LAS f32x4*)(vt + j * 128 + 8 * q) = o0; *(LAS f32x4*)(vt + j * 128 + 8 * q + 4) = o1;
        }
        __syncthreads();
        const int c = tid & 127, tq = tid >> 7, ch = 128 * cc + c;
        float w[31];
#pragma unroll
        for (int k = 0; k < 31; ++k) w[k] = p.in[14][k * 512 + ch];
        const float bias = p.in[15][ch];
        for (int blk = 0; blk < 4; ++blk) {
            const int tb = 32 * tq + 8 * blk;
            float acc[8];
#pragma unroll
            for (int o = 0; o < 8; ++o) acc[o] = bias;
#pragma unroll
            for (int jj = 0; jj < 38; ++jj) {
                const float vv = vt[(tb + jj) * 128 + c];
#pragma unroll
                for (int o = 0; o < 8; ++o) { const int k = jj - o; if (k >= 0 && k <= 30) acc[o] += w[k] * vv; }
            }
#pragma unroll
            for (int o = 0; o < 8; ++o) YC[(size_t)(tb + o) * 512 + ch] = acc[o];
        }
    }
    __syncthreads();
    int tile2 = tile; asm volatile("" : "+s"(tile2));
    gcfp  YC2 = (gcfp)(p.ws + WS_PRIV + (size_t)tile2 * PRIV_BYTES);
    f32x4 lg0 = *(GAS const f32x4*)(p.in[16] + 8 * lane), lg1 = *(GAS const f32x4*)(p.in[16] + 8 * lane + 4), lb0 = *(GAS const f32x4*)(p.in[17] + 8 * lane), lb1 = *(GAS const f32x4*)(p.in[17] + 8 * lane + 4);
#pragma unroll 1
    for (int r0 = wid; r0 < TILE; r0 += 4 * NW) {
        f32x4 ya[4], yb[4]; float s[4], q[4];
#pragma unroll
        for (int i = 0; i < 4; ++i) { ya[i] = *(GAS const f32x4*)(YC2 + (size_t)(r0 + 8 * i) * 512 + 8 * lane); yb[i] = *(GAS const f32x4*)(YC2 + (size_t)(r0 + 8 * i) * 512 + 8 * lane + 4); }
#pragma unroll
        for (int i = 0; i < 4; ++i) s[i] = (ya[i].x + ya[i].y) + (ya[i].z + ya[i].w) + (yb[i].x + yb[i].y) + (yb[i].z + yb[i].w);
#pragma unroll
        for (int i = 0; i < 4; ++i) s[i] = wave_sum_dpp(s[i]) * (1.0f / 512.0f);
#pragma unroll
        for (int i = 0; i < 4; ++i) { ya[i] = ya[i] - s[i]; yb[i] = yb[i] - s[i];
            q[i] = (ya[i].x * ya[i].x + ya[i].y * ya[i].y) + (ya[i].z * ya[i].z + ya[i].w * ya[i].w) + (yb[i].x * yb[i].x + yb[i].y * yb[i].y) + (yb[i].z * yb[i].z + yb[i].w * yb[i].w); }
#pragma unroll
        for (int i = 0; i < 4; ++i) q[i] = wave_sum_dpp(q[i]);
#pragma unroll
        for (int i = 0; i < 4; ++i) {
            const float rstd = 1.0f / sqrtf(q[i] * (1.0f / 512.0f) + EPS);
            const f32x4 n0 = ya[i] * rstd * lg0 + lb0, n1 = yb[i] * rstd * lg1 + lb1;
            float o[8] = {n0.x, n0.y, n0.z, n0.w, n1.x, n1.y, n1.z, n1.w};
#pragma unroll
            for (int e = 0; e < 8; ++e) o[e] = o[e] / (1.0f + __expf(-o[e]));
            u32x4 wv; wv.x = pk2(o[0], o[1]); wv.y = pk2(o[2], o[3]); wv.z = pk2(o[4], o[5]); wv.w = pk2(o[6], o[7]);
            *(GAS u32x4*)(ACT + (size_t)(r0 + 8 * i) * 1024 + 512 + 8 * lane) = wv;
        }
    }
}

__device__ void phaseA(const KP& p, LAS unsigned char* lds, int tile, int, int wid, int) {
    int lane = lane_id(); int tid = wid * 64 + lane; (void)tid;
    OPAQUE_S(tile); OPAQUE_V(lane);
    gucp XQ = p.ws + WS_XQ + (size_t)tile * TILE * 1024; gfp SX = (gfp)(p.ws + WS_SX) + (size_t)tile * TILE;
    rmsnorm_tile_q8(p.in[0] + (size_t)tile * TILE * D, p.in[1], XQ, SX, wid, lane);
    __syncthreads();
    gbp  Z = (gbp)(p.ws + WS_Z) + (size_t)tile * TILE * 1536;
#pragma unroll 1
    for (int nt = 0; nt < 6; ++nt) {
        i32x16 acc[2][2]; EpiSc es;
        load_episc(es, (gcfp)SX, (gcfp)(p.ws + WS_WSC) + WSC_WIN + nt * 256, wid, lane);
        gemm_tile_i8(lds, XQ, 1024, p.ws + WS_WIN8 + (size_t)nt * 256 * 1024, 1024, 1024, acc, wid, lane);
        gbp  zl = launder(Z + (size_t)GEMM_RB(wid, lane) * 1536 + nt * 256 + GEMM_CB(wid, lane));
        GEMM_FOR_FRAGS_I(acc, { gbp zg = launder(zl + fo_r * 1536 + fo_c);
            _Pragma("unroll") for (int i4 = 0; i4 < 16; i4 += 4) { _Pragma("unroll") for (int i = i4; i < i4 + 4; ++i) zg[FR_ROW(i) * 1536] = (bf16)f2bf((float)fr[i] * EPI_SCALE(es, i)); asm volatile("" ::: "memory"); } });
    }
    __syncthreads();
    s5_tile<false>(p, lds, tile, wid, lane);
}

__device__ void mixer_tile(const KP& p, LAS unsigned char* lds, int tile, int, int wid, int) {
    int lane = lane_id(); int tid = wid * 64 + lane; (void)tid;
    OPAQUE_S(tile); OPAQUE_V(lane);
    gbp  ACT = (gbp)(p.ws + WS_ACT) + (size_t)tile * TILE * 1024;
    gcbp  YS = (gcbp)(p.ws + WS_PRIV + (size_t)tile * PRIV_BYTES + 262144);
    s5_tile<true>(p, lds, tile, wid, lane);
    __syncthreads();
    conv_tile(p, lds, tile, tid, wid, lane);
    __syncthreads();
    gucp XQ = p.ws + WS_XQ + (size_t)tile * TILE * 1024; gfp SX = (gfp)(p.ws + WS_SX) + (size_t)tile * TILE;
    quant_tile_bf16<512>(YS, 512, XQ, SX, wid, lane);
    __syncthreads();
#pragma unroll 1
    for (int nt = 0; nt < 2; ++nt) {
        i32x16 acc[2][2]; EpiSc es;
        load_episc(es, (gcfp)SX, (gcfp)(p.ws + WS_WSC) + WSC_WGLU + nt * 256, wid, lane);
        gemm_tile_i8(lds, XQ, 1024, p.ws + WS_WGLU + (size_t)nt * 256 * 512, 512, 512, acc, wid, lane);
        gcbp  yl = launder(YS + (size_t)GEMM_RB(wid, lane) * 512 + nt * 256 + GEMM_CB(wid, lane));
        gbp  al = launder(ACT + (size_t)GEMM_RB(wid, lane) * 1024 + nt * 256 + GEMM_CB(wid, lane));
        bf16 t[2][2][16];
#pragma unroll
        for (int m = 0; m < 2; ++m)
#pragma unroll
            for (int n = 0; n < 2; ++n) { gcbp yg = launder(yl + m * 32 * 512 + n * 32);
#pragma unroll
                for (int i = 0; i < 16; ++i) t[m][n][i] = yg[FR_ROW(i) * 512]; }
        GEMM_FOR_FRAGS_I(acc, { gbp ag = launder(al + fo_r * 1024 + fo_c);
            _Pragma("unroll") for (int i = 0; i < 16; ++i) ag[FR_ROW(i) * 1024] = (bf16)f2bf(bf2f(t[_m][_n][i]) / (1.0f + __expf(-(float)fr[i] * EPI_SCALE(es, i)))); });
    }
    __syncthreads();
    OPAQUE_S(tile); OPAQUE_V(lane);
    gcfp  xin = p.in[0] + (size_t)tile * TILE * D; gbp  XB = XB_TILE(p, tile);
    quant_tile_bf16<1024>(ACT, 1024, XQ, SX, wid, lane);
    __syncthreads();
#pragma unroll 1
    for (int nt = 0; nt < 4; ++nt) {
        i32x16 acc[2][2]; EpiSc es;
        load_episc(es, (gcfp)SX, (gcfp)(p.ws + WS_WSC) + WSC_WOUT + nt * 256, wid, lane);
        gemm_tile_i8(lds, XQ, 1024, p.ws + WS_WOUT + (size_t)nt * 256 * 1024, 1024, 1024, acc, wid, lane);
        gcfp  xl = launder(xin + (size_t)GEMM_RB(wid, lane) * D + nt * 256 + GEMM_CB(wid, lane));
        gbp  ol = launder(XB + (size_t)GEMM_RB(wid, lane) * D + nt * 256 + GEMM_CB(wid, lane));
        float t[2][2][16];
#pragma unroll
        for (int m = 0; m < 2; ++m)
#pragma unroll
            for (int n = 0; n < 2; ++n) { gcfp xg = launder(xl + m * 32 * D + n * 32);
#pragma unroll
                for (int i = 0; i < 16; ++i) t[m][n][i] = xg[FR_ROW(i) * D]; }
        GEMM_FOR_FRAGS_I(acc, { gbp og = launder(ol + fo_r * D + fo_c);
            _Pragma("unroll") for (int i = 0; i < 16; ++i) og[FR_ROW(i) * D] = (bf16)f2bf(t[_m][_n][i] + (float)fr[i] * EPI_SCALE(es, i)); });
    }
    __syncthreads();
}

typedef __bf16 bf16x2_t __attribute__((ext_vector_type(2)));
__device__ __forceinline__ float dot2bf(unsigned a, unsigned b, float c) { return __builtin_amdgcn_fdot2_f32_bf16(__builtin_bit_cast(bf16x2_t, a), __builtin_bit_cast(bf16x2_t, b), c, false); }
__device__ __forceinline__ int f2sort(float f) { const int b = __builtin_bit_cast(int, f); return b ^ ((b >> 31) & 0x7fffffff); }
__device__ __forceinline__ float sort2f(int s) { const int b = s ^ ((s >> 31) & 0x7fffffff); return __builtin_bit_cast(float, b); }
__device__ __forceinline__ void sort16_desc(int (&v)[16]) {
#pragma unroll
    for (int k = 2; k <= 16; k <<= 1)
#pragma unroll
        for (int j = k >> 1; j > 0; j >>= 1)
#pragma unroll
            for (int i = 0; i < 16; ++i) { const int l = i ^ j; if (l > i) { const bool desc = ((i & k) == 0); const int a = v[i], b = v[l], mx = max(a, b), mn = min(a, b); v[i] = desc ? mx : mn; v[l] = desc ? mn : mx; } }
}
__device__ __forceinline__ void bitonic_merge16_desc(int (&v)[16]) {
#pragma unroll
    for (int j = 8; j > 0; j >>= 1)
#pragma unroll
        for (int i = 0; i < 16; ++i) { const int l = i ^ j; if (l > i) { const int a = v[i], b = v[l]; v[i] = max(a, b); v[l] = min(a, b); } }
}
__device__ __forceinline__ void merge_top16(int (&a)[16], const int (&b)[16]) {
#pragma unroll
    for (int i = 0; i < 16; ++i) a[i] = max(a[i], b[15 - i]);
    bitonic_merge16_desc(a);
}

constexpr size_t PRIV_LISTS = 0;

__device__ __forceinline__ void grid_barrier(gucp ws, unsigned idx, int wid);
__device__ void peer_tile(const KP& p, LAS unsigned char* lds, int layer, int tile, int, int wid, int) {
    int lane = lane_id(); int tid = wid * 64 + lane; (void)tid;
    OPAQUE_S(tile); OPAQUE_V(lane); OPAQUE_V(tid);
    gbp ACT = (gbp)(p.ws + WS_ACT) + (size_t)tile * TILE * 1024;
    gbp XB = XB_TILE(p, tile);
    GAS int* LISTS = (GAS int*)(layer == 0 ? p.ws + WS_PRIV + (size_t)tile * PRIV_BYTES + PRIV_LISTS : p.ws + WS_ACT + (size_t)tile * TILE * 2048);
    gcucp WQ = p.ws + WS_WQ8 + (size_t)layer * 2048 * 1024;
    const int lr = lane & 31, lh = lane >> 5;
    rmsnorm_tile_q8_bf(XB, p.in[2] + layer * D, p.ws + WS_XQ + (size_t)tile * TILE * 1024, (gfp)(p.ws + WS_SX) + (size_t)tile * TILE, wid, lane);
    __syncthreads();
#pragma unroll 1
    for (int h = 0; h < 8; ++h) {
        {
            const int c = wid >> 2, tg = wid & 3;
            const float sxs = ((gcfp)(p.ws + WS_SX))[(size_t)tile * TILE + tg * 32 + lr];
            gcfp swl = (gcfp)(p.ws + WS_WSC) + WSC_WQ + layer * 2048 + h * 256 + c * 128;
            float smf[4];
#pragma unroll
            for (int mf = 0; mf < 4; ++mf) smf[mf] = swl[mf * 32] * sxs;
            i32x16 sc[4];
            gemm_scores_i8(lds, p.ws + WS_XQ + (size_t)tile * TILE * 1024, 1024, WQ + (size_t)h * 256 * 1024, 1024, 1024, sc, wid, lane);
            int best[16];
#pragma unroll
            for (int mf = 0; mf < 4; ++mf) {
                int v[16];
#pragma unroll
                for (int i = 0; i < 16; ++i) v[i] = (f2sort((float)sc[mf][i] * smf[mf]) & ~0x7F) | (mf * 32 + FR_ROW(i) + 4 * lh);
                sort16_desc(v);
                if (mf == 0) {
#pragma unroll
                    for (int i = 0; i < 16; ++i) best[i] = v[i];
                } else merge_top16(best, v);
            }
            int oth[16];
#pragma unroll
            for (int i = 0; i < 16; ++i) oth[i] = __shfl_xor(best[i], 32);
            merge_top16(best, oth);
            GAS int* dst = LISTS + ((size_t)(h * 2 + c) * 128 + tg * 32 + lr) * 16 + lh * 8;
            typedef int i32x4 __attribute__((ext_vector_type(4)));
            i32x4 o0, o1;
            if (lh == 0) { o0 = (i32x4){best[0], best[1], best[2], best[3]}; o1 = (i32x4){best[4], best[5], best[6], best[7]}; }
            else { o0 = (i32x4){best[8], best[9], best[10], best[11]}; o1 = (i32x4){best[12], best[13], best[14], best[15]}; }
            *(GAS i32x4*)dst = o0; *(GAS i32x4*)(dst + 4) = o1;
        }
    }
    __syncthreads();
    {
        OPAQUE_S(tile); OPAQUE_V(tid);
        GAS int* IDS = (GAS int*)(p.ws + WS_IDS) + (size_t)tile * TILE * 128;
        gfp GA = (gfp)(p.ws + WS_GATES) + (size_t)tile * TILE * 128; gfp GB = (gfp)(p.ws + WS_GB) + (size_t)tile * TILE * 128;
        gcfp SU = (gcfp)(p.ws + WS_SU) + layer * 16384; gcfp SV = (gcfp)(p.ws + WS_SV) + layer * 16384; gcfp SX = (gcfp)(p.ws + WS_SX) + (size_t)tile * TILE;
        typedef int i32x4 __attribute__((ext_vector_type(4)));
#pragma unroll 1
        for (int rep = 0; rep < 2; ++rep) {
            const int idx = tid + rep * NT, t = idx & 127, h = idx >> 7;
            GAS const int* la = LISTS + ((size_t)(h * 2 + 0) * 128 + t) * 16;
            GAS const int* lb = LISTS + ((size_t)(h * 2 + 1) * 128 + t) * 16;
            float va[16], vb[16]; int ka[16], kb[16];
#pragma unroll
            for (int q = 0; q < 4; ++q) { const i32x4 a4 = *(GAS const i32x4*)(la + 4 * q), b4 = *(GAS const i32x4*)(lb + 4 * q);
#pragma unroll
                for (int e = 0; e < 4; ++e) { va[4 * q + e] = sort2f(a4[e] & ~0x7F); vb[4 * q + e] = sort2f(b4[e] & ~0x7F); ka[4 * q + e] = (a4[e] & 0x7F) << 7; kb[4 * q + e] = b4[e] & 0x7F; } }
            int best[16];
            constexpr int IMIN = (int)0x80000000;
#pragma unroll
            for (int grp = 0; grp < 4; ++grp) {
                int v[16];
#pragma unroll
                for (int e = 0; e < 16; ++e) v[e] = IMIN;
                {
                    int n = 0;
#pragma unroll
                    for (int i = 0; i < 16; ++i)
#pragma unroll
                        for (int j = 0; j < 16; ++j) if ((i + 1) * (j + 1) <= 16) { if (n >= 16 * grp && n < 16 * grp + 16) v[n - 16 * grp] = ((f2sort(va[i] + vb[j]) + 0x2000) & ~0x3FFF) | ka[i] | kb[j]; ++n; }
                }
                sort16_desc(v);
                if (grp == 0) {
#pragma unroll
                    for (int e = 0; e < 16; ++e) best[e] = v[e];
                } else merge_top16(best, v);
            }
            float ev[16]; float sum = 0.f; const float mx = sort2f(best[0] & ~0x3FFF);
#pragma unroll
            for (int e = 0; e < 16; ++e) { ev[e] = __expf(sort2f(best[e] & ~0x3FFF) - mx); sum += ev[e]; }
            const float inv = 1.0f / sum;
            int ids[16];
#pragma unroll
            for (int e = 0; e < 16; ++e) ids[e] = best[e] & 0x3FFF;
            GAS int* io = IDS + (size_t)t * 128 + h * 16; gfp ga = GA + (size_t)t * 128 + h * 16; gfp gb = GB + (size_t)t * 128 + h * 16;
            const float sx = SX[t];
            float fa[16], fb[16];
#pragma unroll
            for (int e = 0; e < 16; ++e) { fa[e] = SU[ids[e]] * sx; fb[e] = ev[e] * inv * SV[ids[e]]; }
#pragma unroll
            for (int q = 0; q < 4; ++q) { *(GAS i32x4*)(io + 4 * q) = (i32x4){ids[4 * q], ids[4 * q + 1], ids[4 * q + 2], ids[4 * q + 3]};
                *(GAS f32x4*)(ga + 4 * q) = (f32x4){fa[4 * q], fa[4 * q + 1], fa[4 * q + 2], fa[4 * q + 3]};
                *(GAS f32x4*)(gb + 4 * q) = (f32x4){fb[4 * q], fb[4 * q + 1], fb[4 * q + 2], fb[4 * q + 3]}; }
        }
    }
    __syncthreads();
    if (layer == 1) grid_barrier(p.ws, 1, wid);
    {
        OPAQUE_S(tile); OPAQUE_V(lane);
        gcucp PU = (gcucp)(p.ws + WS_PU) + (size_t)layer * 16384 * 1024;
        gcucp PV = (gcucp)(p.ws + WS_PV) + (size_t)layer * 16384 * 1024;
        GAS const int* IDS = (GAS const int*)(p.ws + WS_IDS) + (size_t)tile * TILE * 128;
        gcfp GA = (gcfp)(p.ws + WS_GATES) + (size_t)tile * TILE * 128; gcfp GB = (gcfp)(p.ws + WS_GB) + (size_t)tile * TILE * 128;
        typedef int i32x4 __attribute__((ext_vector_type(4)));
        constexpr int SW_TOK = 4, SW_N = 16 / SW_TOK, SW_PAIRS = SW_TOK * 128, PB = 8;
        const __amdgpu_buffer_rsrc_t rsu = __builtin_amdgcn_make_buffer_rsrc((void*)PU, (short)0, 16384 * 1024, 0x00020000);
        const __amdgpu_buffer_rsrc_t rsv = __builtin_amdgcn_make_buffer_rsrc((void*)PV, (short)0, 16384 * 1024, 0x00020000);
        LAS unsigned char* wl = lds + wid * 13312;
        LAS unsigned* list = (LAS unsigned*)wl; LAS unsigned char* xl = wl + 4096; LAS unsigned* hist = (LAS unsigned*)(wl + 12288);
#pragma unroll 1
        for (int sweep = 0; sweep < SW_N; ++sweep) {
            const int tok0 = wid * 16 + sweep * SW_TOK;
            __syncthreads();
            hist[lane] = 0u; hist[lane + 64] = 0u;
            unsigned key[2 * SW_TOK];
#pragma unroll
            for (int s = 0; s < SW_TOK; ++s) {
                *(LAS i32x4*)(xl + s * 1024 + 16 * lane) = *(GAS const i32x4*)(p.ws + WS_XQ + ((size_t)tile * TILE + tok0 + s) * 1024 + 16 * lane);
                key[2 * s] = (unsigned)IDS[(size_t)(tok0 + s) * 128 + lane] | (unsigned)(s << 14) | ((unsigned)lane << 17);
                key[2 * s + 1] = (unsigned)IDS[(size_t)(tok0 + s) * 128 + 64 + lane] | (unsigned)(s << 14) | ((unsigned)(lane + 64) << 17);
            }
#pragma unroll
            for (int i = 0; i < 2 * SW_TOK; ++i) __hip_atomic_fetch_add(hist + ((key[i] & 0x3fffu) >> 7), 1u, __ATOMIC_RELAXED, __HIP_MEMORY_SCOPE_WORKGROUP);
            {
                const unsigned h0 = hist[2 * lane], h1 = hist[2 * lane + 1];
                unsigned incl = h0 + h1;
#pragma unroll
                for (int o = 1; o < 64; o <<= 1) { const unsigned t = __shfl_up(incl, o); if (lane >= o) incl += t; }
                const unsigned excl = incl - (h0 + h1);
                hist[2 * lane] = excl; hist[2 * lane + 1] = excl + h0;
            }
#pragma unroll
            for (int i = 0; i < 2 * SW_TOK; ++i) { const unsigned pos = __hip_atomic_fetch_add(hist + ((key[i] & 0x3fffu) >> 7), 1u, __ATOMIC_RELAXED, __HIP_MEMORY_SCOPE_WORKGROUP); list[pos] = key[i]; }
            typedef _Float16 f16x4 __attribute__((ext_vector_type(4)));
            f32x4 accq[16]; float wsumv = 0.f;
#pragma unroll
            for (int q = 0; q < 16; ++q) accq[q] = (f32x4){0.f, 0.f, 0.f, 0.f};
#pragma unroll 1
            for (int chunk = 0; chunk < SW_PAIRS / 64; ++chunk) {
                const unsigned k64 = list[chunk * 64 + lane];
                const int sl = (k64 >> 14) & 7, jl = k64 >> 17;
                const float fa64 = GA[(size_t)(tok0 + sl) * 128 + jl], fb64 = GB[(size_t)(tok0 + sl) * 128 + jl];
#pragma unroll 1
                for (int i = 0; i < 64; i += PB) {
                    i32x4 uu[PB]; u32x4 vv[PB]; int sk[PB];
#pragma unroll
                    for (int k = 0; k < PB; ++k) {
                        const unsigned kk = (unsigned)__builtin_amdgcn_readlane((int)k64, i + k);
                        const int eo = (int)((kk & 0x3fffu) << 10); sk[k] = (kk >> 14) & 7;
                        uu[k] = __builtin_bit_cast(i32x4, __builtin_amdgcn_raw_buffer_load_b128(rsu, 16 * lane, eo, 0));
                        vv[k] = __builtin_bit_cast(u32x4, __builtin_amdgcn_raw_buffer_load_b128(rsv, 16 * lane, eo, 0));
                    }
                    float dd[PB];
#pragma unroll
                    for (int k = 0; k < PB; ++k) {
                        const i32x4 xx = *(const LAS i32x4*)(xl + sk[k] * 1024 + 16 * lane);
                        int d = __builtin_amdgcn_sdot4(uu[k].x, xx.x, 0, false); d = __builtin_amdgcn_sdot4(uu[k].y, xx.y, d, false);
                        d = __builtin_amdgcn_sdot4(uu[k].z, xx.z, d, false); d = __builtin_amdgcn_sdot4(uu[k].w, xx.w, d, false);
                        dd[k] = (float)d;
                    }
                    float tot;
                    {
                        const bool b0 = lane & 1, b1 = lane & 2, b2 = lane & 4;
                        float r1[4], r2[2];
#pragma unroll
                        for (int m = 0; m < 4; ++m) { const float keep = b0 ? dd[2 * m + 1] : dd[2 * m], send = b0 ? dd[2 * m] : dd[2 * m + 1]; r1[m] = keep + dppf<0xB1>(send); }
#pragma unroll
                        for (int m = 0; m < 2; ++m) { const float keep = b1 ? r1[2 * m + 1] : r1[2 * m], send = b1 ? r1[2 * m] : r1[2 * m + 1]; r2[m] = keep + dppf<0x4E>(send); }
                        const float keep = b2 ? r2[1] : r2[0], send = b2 ? r2[0] : r2[1];
                        tot = keep + __builtin_bit_cast(float, __builtin_amdgcn_ds_swizzle(__builtin_bit_cast(int, send), 0x101f));
                        tot += dppf<0x128>(tot);
                        auto s16 = __builtin_amdgcn_permlane16_swap(__float_as_uint(tot), __float_as_uint(tot), false, false);
                        tot = __uint_as_float(s16[0]) + __uint_as_float(s16[1]);
                        auto s32 = __builtin_amdgcn_permlane32_swap(__float_as_uint(tot), __float_as_uint(tot), false, false);
                        tot = __uint_as_float(s32[0]) + __uint_as_float(s32[1]);
                    }
                    const float fav = __shfl(fa64, i + (lane & 7)), fbv = __shfl(fb64, i + (lane & 7));
                    const float wv = (float)(_Float16)(gelu_exact(tot * fav) * fbv * 4096.0f);
#pragma unroll
                    for (int g = 0; g < PB / 4; ++g) {
                        float sel[4];
#pragma unroll
                        for (int k = 0; k < 4; ++k) { const float w = __builtin_bit_cast(float, __builtin_amdgcn_readlane(__builtin_bit_cast(int, wv), 4 * g + k));
                            sel[k] = (sk[4 * g + k] == (lane & 3)) ? w : 0.f; wsumv += sel[k]; }
                        const f16x4 am = {(_Float16)sel[0], (_Float16)sel[1], (_Float16)sel[2], (_Float16)sel[3]};
#pragma unroll
                        for (int q = 0; q < 16; ++q) {
                            constexpr unsigned SELB = 0x0c000c00u; const unsigned selq = SELB | ((4u + (q & 3)) << 16) | (unsigned)(q & 3);
                            u32x2 bw; bw.x = __builtin_amdgcn_perm(vv[4 * g + 1][q >> 2], vv[4 * g + 0][q >> 2], selq); bw.y = __builtin_amdgcn_perm(vv[4 * g + 3][q >> 2], vv[4 * g + 2][q >> 2], selq);
                            accq[q] = __builtin_amdgcn_mfma_f32_4x4x4f16(am, __builtin_bit_cast(f16x4, bw), accq[q], 0, 0, 0);
                        }
                    }
                }
            }
#pragma unroll
            for (int s = 0; s < SW_TOK; ++s) {
                gbp xr = XB + (size_t)(tok0 + s) * D + 16 * lane;
                const float corr = __builtin_bit_cast(float, __builtin_amdgcn_readlane(__builtin_bit_cast(int, wsumv), s)) * (128.0f / 4096.0f);
                const u32x4 r0 = *(GAS const u32x4*)xr, r1 = *(GAS const u32x4*)(xr + 8);
                float xv[16];
#pragma unroll
                for (int q = 0; q < 8; ++q) { const unsigned w = q < 4 ? r0[q & 3] : r1[q & 3]; xv[2 * q] = __uint_as_float(w << 16); xv[2 * q + 1] = __uint_as_float(w & 0xffff0000u); }
#pragma unroll
                for (int q = 0; q < 16; ++q) xv[q] += accq[q][s] * 4096.0f - corr;
                if (layer == 0) {
                    u32x4 o0, o1;
#pragma unroll
                    for (int q = 0; q < 4; ++q) { o0[q] = pk2(xv[2 * q], xv[2 * q + 1]); o1[q] = pk2(xv[8 + 2 * q], xv[8 + 2 * q + 1]); }
                    *(GAS u32x4*)xr = o0; *(GAS u32x4*)(xr + 8) = o1;
                } else {
                    float ss = 0.f;
#pragma unroll
                    for (int q = 0; q < 16; ++q) ss += xv[q] * xv[q];
                    ss = wave_sum_dpp(ss);
                    const float rstd = 1.0f / sqrtf(ss * (1.0f / D) + EPS);
                    gfp orow = p.out + ((size_t)tile * TILE + tok0 + s) * D + 16 * lane; gcfp gf = p.in[3] + 16 * lane;
#pragma unroll
                    for (int q = 0; q < 4; ++q) { const f32x4 g4 = *(GAS const f32x4*)(gf + 4 * q);
                        *(GAS f32x4*)(orow + 4 * q) = (f32x4){xv[4 * q] * rstd * g4.x, xv[4 * q + 1] * rstd * g4.y, xv[4 * q + 2] * rstd * g4.z, xv[4 * q + 3] * rstd * g4.w}; }
                }
            }
        }
    }
    __syncthreads();
}

__device__ void qkv_tile(const KP& p, LAS unsigned char* lds, int tile, int, int wid, int) {
    int lane = lane_id(); int tid = wid * 64 + lane; (void)tid;
    OPAQUE_S(tile); OPAQUE_V(lane); OPAQUE_V(tid);
    gcbp XB = XB_TILE(p, tile);
    gbp QKV = (gbp)(p.ws + WS_PRIV + (size_t)tile * PRIV_BYTES);
    gucp XQ = p.ws + WS_XQ + (size_t)tile * TILE * 1024; gfp SX = (gfp)(p.ws + WS_SX) + (size_t)tile * TILE;
    rmsnorm_tile_q8_bf(XB, p.in[1] + D, XQ, SX, wid, lane);
    __syncthreads();
    typedef float f32x2r __attribute__((ext_vector_type(2)));
    const int wc = wid & 3, lr = lane & 31;
    f32x2r cs[2][16];
    {
        GAS const f32x2r* CS = (GAS const f32x2r*)(p.ws + WS_ROPE) + ((size_t)((tile % TILES_PER_SEQ) * TILE + GEMM_RB(wid, lane)) * 8 + (lr & 7));
#pragma unroll
        for (int m = 0; m < 2; ++m)
#pragma unroll
            for (int i = 0; i < 16; ++i) cs[m][i] = CS[(size_t)(32 * m + FR_ROW(i)) * 8];
    }
    const float sgn = (lr & 8) ? 1.0f : -1.0f;
#pragma unroll 1
    for (int nt = 0; nt < 5; ++nt) {
        i32x16 acc[2][2]; EpiSc es;
        load_episc(es, (gcfp)SX, (gcfp)(p.ws + WS_WSC) + WSC_WQKV + nt * 256, wid, lane);
        float bias[2];
#pragma unroll
        for (int n = 0; n < 2; ++n) bias[n] = p.in[20][nt * 256 + GEMM_CB(wid, lane) + 32 * n];
        gemm_tile_i8(lds, XQ, 1024, p.ws + WS_WQKV8 + (size_t)nt * 256 * 1024, 1024, 1024, acc, wid, lane);
        gbp ql = launder(QKV + (size_t)GEMM_RB(wid, lane) * 1280 + nt * 256 + GEMM_CB(wid, lane));
        const bool rot = nt < 4 || wc < 2;
        GEMM_FOR_FRAGS_I(acc, { gbp qg = launder(ql + fo_r * 1280 + fo_c);
            _Pragma("unroll") for (int i4 = 0; i4 < 16; i4 += 4) { _Pragma("unroll") for (int i = i4; i < i4 + 4; ++i) {
                float v = (float)fr[i] * EPI_SCALE(es, i) + bias[_n];
                if (_n == 0) { const float pv = dppf<0x128>(v);
                    const float r = v * cs[_m][i].x + pv * (sgn * cs[_m][i].y); v = (rot && lr < 16) ? r : v; }
                qg[FR_ROW(i) * 1280] = (bf16)f2bf(v); } asm volatile("" ::: "memory"); } });
    }
    __syncthreads();
}

constexpr int AT_K = 0, AT_VT = 65536, AT_VROW = 520;
__device__ void attn_tile(const KP& p, LAS unsigned char* lds, int tile, int, int wid, int) {
    int lane = lane_id(); int tid = wid * 64 + lane; (void)tid;
    OPAQUE_S(tile); OPAQUE_V(lane); OPAQUE_V(tid);
    const bool has_prev = (tile % TILES_PER_SEQ) != 0;
    gcbp QKVc = (gcbp)(p.ws + WS_PRIV + (size_t)tile * PRIV_BYTES);
    gcbp QKVp = (gcbp)(p.ws + WS_PRIV + (size_t)(tile - 1) * PRIV_BYTES);
    gbp ATT = (gbp)(p.ws + WS_ACT) + (size_t)tile * TILE * 1024;
    __syncthreads();
    for (int idx = tid; idx < 2 * 256 * 8; idx += NT) {
        const int c = idx & 7, kw = (idx >> 3) & 255, kv = idx >> 11;
        u32x4 kk = {0u, 0u, 0u, 0u}, vv = {0u, 0u, 0u, 0u};
        if (kw >= 128 || has_prev) {
            gcbp row = (kw >= 128 ? QKVc + (size_t)(kw - 128) * 1280 : QKVp + (size_t)kw * 1280);
            kk = *(GAS const u32x4*)(row + 1024 + kv * 64 + c * 8);
            vv = *(GAS const u32x4*)(row + 1152 + kv * 64 + c * 8);
        }
        *(LAS u32x4*)(lds + AT_K + (kv * 256 + kw) * 128 + ((c ^ ((kw >> 1) & 7)) * 16)) = kk;
        LAS unsigned char* vt = lds + AT_VT + (kv * 64 + c * 8) * AT_VROW + kw * 2;
        *(LAS bf16*)(vt + 0 * AT_VROW) = (bf16)(vv.x & 0xffff); *(LAS bf16*)(vt + 1 * AT_VROW) = (bf16)(vv.x >> 16);
        *(LAS bf16*)(vt + 2 * AT_VROW) = (bf16)(vv.y & 0xffff); *(LAS bf16*)(vt + 3 * AT_VROW) = (bf16)(vv.y >> 16);
        *(LAS bf16*)(vt + 4 * AT_VROW) = (bf16)(vv.z & 0xffff); *(LAS bf16*)(vt + 5 * AT_VROW) = (bf16)(vv.z >> 16);
        *(LAS bf16*)(vt + 6 * AT_VROW) = (bf16)(vv.w & 0xffff); *(LAS bf16*)(vt + 7 * AT_VROW) = (bf16)(vv.w >> 16);
    }
    __syncthreads();
    const int lr = lane & 31, lh = lane >> 5, kv = wid >> 2;
    LAS unsigned char* Kl = lds + AT_K + kv * 256 * 128;
    LAS unsigned char* Vl = lds + AT_VT + kv * 64 * AT_VROW;
#pragma unroll 1
    for (int unit = 0; unit < 8; ++unit) {
        const int head = wid * 2 + (unit >> 2), qf = unit & 3;
        bf16x8 qb[4];
#pragma unroll
        for (int ks = 0; ks < 4; ++ks) qb[ks] = *(GAS const bf16x8*)(QKVc + (size_t)(qf * 32 + lr) * 1280 + head * 64 + ks * 16 + lh * 8);
        f32x16 s[5];
#pragma unroll
        for (int f = 0; f < 5; ++f) {
#pragma unroll
            for (int i = 0; i < 16; ++i) s[f][i] = 0.f;
            const int row = (qf + f) * 32 + lr;
#pragma unroll
            for (int ks = 0; ks < 4; ++ks) { const bf16x8 ka = *(const LAS bf16x8*)(Kl + row * 128 + (((2 * ks + lh) ^ ((row >> 1) & 7)) * 16));
                s[f] = __builtin_amdgcn_mfma_f32_32x32x16_bf16(ka, qb[ks], s[f], 0, 0, 0); }
        }
        const int q = qf * 32 + lr;
        const float sink = p.in[21][head];
        float mx = sink;
#pragma unroll
        for (int f = 0; f < 5; ++f)
#pragma unroll
            for (int i = 0; i < 16; ++i) { const int kw = (qf + f) * 32 + FR_ROW(i) + 4 * lh;
                const bool ok = (kw >= q + 1) && (kw <= q + 128) && (kw >= 128 || has_prev);
                const float v = ok ? s[f][i] * 0.125f : -INFINITY; s[f][i] = v; mx = fmaxf(mx, v); }
        mx = fmaxf(mx, __shfl_xor(mx, 32));
        float sum = 0.f;
#pragma unroll
        for (int f = 0; f < 5; ++f)
#pragma unroll
            for (int i = 0; i < 16; ++i) { const float e = __expf(s[f][i] - mx); s[f][i] = e; sum += e; }
        sum += __shfl_xor(sum, 32);
        sum += __expf(sink - mx);
        const float inv = 1.0f / sum;
        f32x16 o[2];
#pragma unroll
        for (int m = 0; m < 2; ++m)
#pragma unroll
            for (int i = 0; i < 16; ++i) o[m][i] = 0.f;
#pragma unroll
        for (int f = 0; f < 5; ++f)
#pragma unroll
            for (int st = 0; st < 2; ++st) {
                u32x4 pbu; pbu.x = pk2(s[f][8 * st + 0], s[f][8 * st + 1]); pbu.y = pk2(s[f][8 * st + 2], s[f][8 * st + 3]); pbu.z = pk2(s[f][8 * st + 4], s[f][8 * st + 5]); pbu.w = pk2(s[f][8 * st + 6], s[f][8 * st + 7]);
                const bf16x8 pb = __builtin_bit_cast(bf16x8, pbu);
                const int kb = (qf + f) * 32 + 16 * st + 4 * lh;
#pragma unroll
                for (int m = 0; m < 2; ++m) {
                    const LAS unsigned char* vr = Vl + (m * 32 + lr) * AT_VROW + kb * 2;
                    const u32x2 lo = *(const LAS u32x2*)vr, hi = *(const LAS u32x2*)(vr + 16);
                    u32x4 vau; vau.x = lo.x; vau.y = lo.y; vau.z = hi.x; vau.w = hi.y;
                    o[m] = __builtin_amdgcn_mfma_f32_32x32x16_bf16(__builtin_bit_cast(bf16x8, vau), pb, o[m], 0, 0, 0);
                }
            }
        gbp orow = ATT + (size_t)q * 1024 + head * 64 + 4 * lh;
#pragma unroll
        for (int m = 0; m < 2; ++m)
#pragma unroll
            for (int g4 = 0; g4 < 4; ++g4) { u32x2 w; w.x = pk2(o[m][4 * g4] * inv, o[m][4 * g4 + 1] * inv); w.y = pk2(o[m][4 * g4 + 2] * inv, o[m][4 * g4 + 3] * inv);
                *(GAS u32x2*)(orow + m * 32 + 8 * g4) = w; }
    }
    __syncthreads();
}

__device__ void oproj_tile(const KP& p, LAS unsigned char* lds, int tile, int, int wid, int) {
    int lane = lane_id(); int tid = wid * 64 + lane; (void)tid;
    OPAQUE_S(tile); OPAQUE_V(lane);
    gcbp ATT = (gcbp)(p.ws + WS_ACT) + (size_t)tile * TILE * 1024;
    gbp XB = XB_TILE(p, tile);
    gucp XQ = p.ws + WS_XQ + (size_t)tile * TILE * 1024; gfp SX = (gfp)(p.ws + WS_SX) + (size_t)tile * TILE;
    quant_tile_bf16<1024>(ATT, 1024, XQ, SX, wid, lane);
    __syncthreads();
#pragma unroll 1
    for (int nt = 0; nt < 4; ++nt) {
        i32x16 acc[2][2]; EpiSc es;
        load_episc(es, (gcfp)SX, (gcfp)(p.ws + WS_WSC) + WSC_WO + nt * 256, wid, lane);
        gemm_tile_i8(lds, XQ, 1024, p.ws + WS_WO + (size_t)nt * 256 * 1024, 1024, 1024, acc, wid, lane);
        gbp ol = launder(XB + (size_t)GEMM_RB(wid, lane) * D + nt * 256 + GEMM_CB(wid, lane));
        bf16 t[2][2][16];
#pragma unroll
        for (int m = 0; m < 2; ++m)
#pragma unroll
            for (int n = 0; n < 2; ++n) { gcbp xg = launder((gcbp)ol + m * 32 * D + n * 32);
#pragma unroll
                for (int i = 0; i < 16; ++i) t[m][n][i] = xg[FR_ROW(i) * D]; }
        GEMM_FOR_FRAGS_I(acc, { gbp og = launder(ol + fo_r * D + fo_c);
            _Pragma("unroll") for (int i = 0; i < 16; ++i) og[FR_ROW(i) * D] = (bf16)f2bf(bf2f(t[_m][_n][i]) + (float)fr[i] * EPI_SCALE(es, i)); });
    }
    __syncthreads();
}

template <int R>
__device__ __forceinline__ void rmsnorm_rows_f32(gcfp x0, gcfp g, gfp o0, int lane) {
    f32x4 v[R][4]; float s[R];
#pragma unroll
    for (int i = 0; i < R; ++i)
#pragma unroll
        for (int j = 0; j < 4; ++j) v[i][j] = *(GAS const f32x4*)(x0 + (size_t)i * 8 * D + 4 * lane + 256 * j);
    f32x4 gg[4];
#pragma unroll
    for (int j = 0; j < 4; ++j) gg[j] = *(GAS const f32x4*)(g + 4 * lane + 256 * j);
#pragma unroll
    for (int i = 0; i < R; ++i) { s[i] = 0.f;
#pragma unroll
        for (int j = 0; j < 4; ++j) s[i] += (v[i][j].x * v[i][j].x + v[i][j].y * v[i][j].y) + (v[i][j].z * v[i][j].z + v[i][j].w * v[i][j].w); }
#pragma unroll
    for (int i = 0; i < R; ++i) s[i] = wave_sum_dpp(s[i]);
#pragma unroll
    for (int i = 0; i < R; ++i) { const float rstd = 1.0f / sqrtf(s[i] * (1.0f / D) + EPS);
#pragma unroll
        for (int j = 0; j < 4; ++j) *(GAS f32x4*)(o0 + (size_t)i * 8 * D + 4 * lane + 256 * j) = v[i][j] * rstd * gg[j]; }
}

__device__ __forceinline__ void grid_barrier(gucp ws, unsigned idx, int wid) {
    asm volatile("s_waitcnt vmcnt(0)" ::: "memory");
    __syncthreads();
    if (wid == 0 && lane_id() == 0) {
        __builtin_amdgcn_fence(__ATOMIC_RELEASE, "agent");
        asm volatile("s_waitcnt vmcnt(0)" ::: "memory");
        GAS unsigned* cnt = (GAS unsigned*)(ws + WS_CTL) + 64;
        __hip_atomic_fetch_add(cnt, 1u, __ATOMIC_RELAXED, __HIP_MEMORY_SCOPE_AGENT);
        const unsigned target = idx * gridDim.x;
        unsigned spins = 0;
        while (__hip_atomic_load(cnt, __ATOMIC_RELAXED, __HIP_MEMORY_SCOPE_AGENT) < target && ++spins < (1u << 26)) __builtin_amdgcn_s_sleep(1);
        __builtin_amdgcn_fence(__ATOMIC_ACQUIRE, "agent");
        asm volatile("s_waitcnt vmcnt(0)" ::: "memory");
    }
    __syncthreads();
}

__device__ __forceinline__ void tile_publish(GAS unsigned* flags, int tile, int wid) {
    asm volatile("s_waitcnt vmcnt(0)" ::: "memory");
    __syncthreads();
    if (wid == 0 && lane_id() == 0) {
        __builtin_amdgcn_fence(__ATOMIC_RELEASE, "agent");
        asm volatile("s_waitcnt vmcnt(0)" ::: "memory");
        __hip_atomic_store(flags + tile, 1u, __ATOMIC_RELAXED, __HIP_MEMORY_SCOPE_AGENT);
    }
}
__device__ __forceinline__ void tile_wait(GAS unsigned* flags, int first, int count, int wid) {
    if (wid == 0) {
        const int l = lane_id();
        for (unsigned spins = 0; spins < (1u << 24); ++spins) {
            const unsigned f0 = l < count ? __hip_atomic_load(flags + first + l, __ATOMIC_RELAXED, __HIP_MEMORY_SCOPE_AGENT) : 1u;
            const unsigned f1 = l + 64 < count ? __hip_atomic_load(flags + first + 64 + l, __ATOMIC_RELAXED, __HIP_MEMORY_SCOPE_AGENT) : 1u;
            if (__all((f0 & f1) != 0u)) break;
            __builtin_amdgcn_s_sleep(2);
        }
        __builtin_amdgcn_fence(__ATOMIC_ACQUIRE, "agent");
        asm volatile("s_waitcnt vmcnt(0)" ::: "memory");
    }
    __syncthreads();
}

__global__ void __launch_bounds__(NT) fwd_megakernel(Params pa) {
    extern __shared__ __attribute__((aligned(16))) unsigned char lds_raw[];
    LAS unsigned char* lds = (LAS unsigned char*)lds_raw;
    cg::grid_group grid = cg::this_grid();
    const int tid = threadIdx.x, lane = tid & 63, wid = __builtin_amdgcn_readfirstlane(tid >> 6);
    KP p;
#pragma unroll
    for (int i = 0; i < 27; ++i) p.in[i] = (gcfp)pa.in[i];
    p.out = (gfp)pa.out; p.ws = (gucp)pa.ws;

    phase0(p, lds, tid, lane, wid);
    grid.sync();
    const int tile = blockIdx.x;
    phaseA(p, lds, tile, 0, wid, 0);
    {
        GAS unsigned* fl = (GAS unsigned*)(p.ws + WS_CTL) + 256;
        tile_publish(fl, tile, wid);
        const int tl = tile % TILES_PER_SEQ;
        tile_wait(fl, tile - tl, tl, wid);
    }
    mixer_tile(p, lds, tile, 0, wid, 0);
    peer_tile(p, lds, 0, tile, 0, wid, 0);
    qkv_tile(p, lds, tile, 0, wid, 0);
    {
        GAS unsigned* fl = (GAS unsigned*)(p.ws + WS_CTL) + 512;
        tile_publish(fl, tile, wid);
        const int tl = tile % TILES_PER_SEQ;
        tile_wait(fl, tile - 1, tl > 0 ? 1 : 0, wid);
    }
    attn_tile(p, lds, tile, 0, wid, 0);
    oproj_tile(p, lds, tile, 0, wid, 0);
    peer_tile(p, lds, 1, tile, 0, wid, 0);
}

extern "C" void kernel_launch(void* const* d_in, const int* in_sizes, int n_in, void* d_out, int out_size, void* d_ws, size_t ws_size, hipStream_t stream) {
    static int grid_blocks = 0;
    if (grid_blocks == 0) {
        if (n_in != 27 || out_size != T * D || ws_size < WS_END) { fprintf(stderr, "kernel_launch: unexpected shapes (n_in %d out %d ws %zu)\n", n_in, out_size, ws_size); grid_blocks = -1; return; }
        int dev = 0, cus = 0, per_cu = 0;
        hipGetDevice(&dev);
        hipDeviceGetAttribute(&cus, hipDeviceAttributeMultiprocessorCount, dev);
        hipFuncSetAttribute((const void*)fwd_megakernel, hipFuncAttributeMaxDynamicSharedMemorySize, LDS_BYTES);
        hipOccupancyMaxActiveBlocksPerMultiprocessor(&per_cu, (const void*)fwd_megakernel, NT, LDS_BYTES);
        if (per_cu < 1) { fprintf(stderr, "kernel_launch: occupancy query says %d blocks per CU\n", per_cu); grid_blocks = -1; return; }
        if (cus * per_cu < NTILES) { fprintf(stderr, "kernel_launch: needs %d co-resident workgroups, the device holds %d\n", NTILES, cus * per_cu); grid_blocks = -1; return; }
        grid_blocks = NTILES;
    }
    if (grid_blocks < 0) return;
    (void)hipMemsetAsync((char*)d_ws + WS_CTL, 0, 8192, stream);
    Params p{};
    for (int i = 0; i < 27; ++i) p.in[i] = (const float*)d_in[i];
    p.out = (float*)d_out; p.ws = (unsigned char*)d_ws;
    void* args[] = {&p};
    hipError_t e = hipLaunchCooperativeKernel((const void*)fwd_megakernel, dim3(grid_blocks), dim3(NT), args, LDS_BYTES, stream);
    if (e != hipSuccess) fprintf(stderr, "cooperative launch failed: %s (grid %d)\n", hipGetErrorString(e), grid_blocks);
}
```

```cpp
#include <hip/hip_runtime.h>
#include <hip/hip_cooperative_groups.h>
#include <cstdio>
#include <cstdint>
namespace cg = cooperative_groups;

#define LAS __attribute__((address_space(3)))
#define GAS __attribute__((address_space(1)))
typedef unsigned short bf16;
typedef short bf16x8 __attribute__((ext_vector_type(8)));
typedef float f32x16 __attribute__((ext_vector_type(16)));
typedef float f32x4 __attribute__((ext_vector_type(4)));
typedef unsigned u32x4 __attribute__((ext_vector_type(4)));
typedef unsigned u32x2q __attribute__((ext_vector_type(2)));
typedef unsigned u32x2 __attribute__((ext_vector_type(2)));

constexpr int T = 32768, D = 1024, SEQ = 16384;
constexpr int NT = 512, NW = 8;
constexpr int TILE = 128, NTILES = T / TILE;
constexpr int TILES_PER_SEQ = SEQ / TILE;
constexpr float EPS = 1e-6f;
constexpr int LDS_BYTES = 147456;

constexpr size_t MiB = 1u << 20;
constexpr size_t WS_WIN = 0;
constexpr size_t WS_WIN8 = 27 * MiB;
constexpr size_t WS_WGLU = 3 * MiB;
constexpr size_t WS_WOUT = 4 * MiB;
constexpr size_t WS_WQKV = 6 * MiB;
constexpr size_t WS_WQKV8 = 29 * MiB;
constexpr size_t WS_WO = 9 * MiB;
constexpr size_t WS_WQ = 11 * MiB;
constexpr size_t WS_WQ8 = 160 * MiB - 4 * MiB;
constexpr size_t WS_ROPE = 19 * MiB;
constexpr size_t WS_S5 = 20 * MiB;
constexpr size_t WS_S5E = 21 * MiB;
constexpr size_t WS_WSC = 26 * MiB;
constexpr size_t WSC_WIN = 0, WSC_WQ = 1536, WSC_WQKV = 1536 + 4096, WSC_WGLU = 6912, WSC_WOUT = 7424, WSC_WO = 8448;
constexpr size_t WS_CTL = 31 * MiB;
constexpr size_t WS_PU = 32 * MiB;
constexpr size_t WS_PV = 64 * MiB;
constexpr size_t WS_SU = 96 * MiB;
constexpr size_t WS_SV = 96 * MiB + 131072;
constexpr size_t WS_XQ = 97 * MiB;
constexpr size_t WS_SX = 129 * MiB;
constexpr size_t WS_ACT = 160 * MiB;
constexpr size_t WS_Z = 224 * MiB;
constexpr size_t WS_PRIV = 320 * MiB;
constexpr size_t PRIV_BYTES = 384 * 1024;
constexpr size_t WS_IDS = 416 * MiB;
constexpr size_t WS_GATES = 432 * MiB;
constexpr size_t WS_QT = 448 * MiB;
constexpr size_t WS_GB = 464 * MiB;
constexpr size_t WS_END = 480 * MiB;

struct Params {
    const float* in[27];
    float* out;
    unsigned char* ws;
};
typedef GAS const float* gcfp; typedef GAS float* gfp; typedef GAS bf16* gbp; typedef GAS const bf16* gcbp; typedef GAS unsigned char* gucp; typedef GAS const unsigned char* gcucp;
struct KP {
    gcfp in[27];
    gfp out;
    gucp ws;
};

__device__ __forceinline__ unsigned f2bf(float f) { unsigned u = __builtin_bit_cast(unsigned, f); return (u + 0x7fffu + ((u >> 16) & 1u)) >> 16; }
__device__ __forceinline__ unsigned pk2(float lo, float hi) { return f2bf(lo) | (f2bf(hi) << 16); }
__device__ __forceinline__ float bflo(unsigned u) { return __builtin_bit_cast(float, u << 16); }
__device__ __forceinline__ float bfhi(unsigned u) { return __builtin_bit_cast(float, u & 0xffff0000u); }
__device__ __forceinline__ float bf2f(bf16 h) { return __builtin_bit_cast(float, (unsigned)h << 16); }
__device__ __forceinline__ int lane_id() { return __builtin_amdgcn_mbcnt_hi(~0u, __builtin_amdgcn_mbcnt_lo(~0u, 0u)); }
__device__ __forceinline__ float wave_sum(float v) {
#pragma unroll
    for (int o = 1; o < 64; o <<= 1) v += __shfl_xor(v, o);
    return v;
}

template <int CTRL> __device__ __forceinline__ float dppf(float x) { return __builtin_bit_cast(float, __builtin_amdgcn_mov_dpp(__builtin_bit_cast(int, x), CTRL, 0xf, 0xf, true)); }
__device__ __forceinline__ float wave_sum_dpp(float x) {
    x += dppf<0xB1>(x); x += dppf<0x4E>(x); x += dppf<0x141>(x); x += dppf<0x128>(x);
    auto s = __builtin_amdgcn_permlane16_swap(__float_as_uint(x), __float_as_uint(x), false, false);
    x = __uint_as_float(s[0]) + __uint_as_float(s[1]);
    auto t = __builtin_amdgcn_permlane32_swap(__float_as_uint(x), __float_as_uint(x), false, false);
    return __uint_as_float(t[0]) + __uint_as_float(t[1]);
}
__device__ __forceinline__ float wave_max_dpp(float x) {
    x = fmaxf(x, dppf<0xB1>(x)); x = fmaxf(x, dppf<0x4E>(x)); x = fmaxf(x, dppf<0x141>(x)); x = fmaxf(x, dppf<0x128>(x));
    auto s = __builtin_amdgcn_permlane16_swap(__float_as_uint(x), __float_as_uint(x), false, false);
    x = fmaxf(__uint_as_float(s[0]), __uint_as_float(s[1]));
    auto t = __builtin_amdgcn_permlane32_swap(__float_as_uint(x), __float_as_uint(x), false, false);
    return fmaxf(__uint_as_float(t[0]), __uint_as_float(t[1]));
}

__device__ __forceinline__ void transpose_item(gcfp  W, int K, int N, gbp  WT, LAS float* scr, int item, int lane) {
    const int nblk = N / 32, kb = item / nblk, nb = item % nblk, k0 = 64 * kb, n0 = 32 * nb;
#pragma unroll 8
    for (int i = 0; i < 32; ++i) { const int kk = 2 * i + (lane >> 5); scr[kk * 33 + (lane & 31)] = W[(size_t)(k0 + kk) * N + n0 + (lane & 31)]; }
    asm volatile("s_waitcnt lgkmcnt(0)" ::: "memory");
    const int c = lane & 7;
#pragma unroll
    for (int j = 0; j < 4; ++j) { const int n = (lane >> 3) + 8 * j; const LAS float* s = scr + (8 * c) * 33 + n;
        u32x4 o; o.x = pk2(s[0 * 33], s[1 * 33]); o.y = pk2(s[2 * 33], s[3 * 33]); o.z = pk2(s[4 * 33], s[5 * 33]); o.w = pk2(s[6 * 33], s[7 * 33]);
        *(GAS u32x4*)(WT + (size_t)(n0 + n) * K + k0 + 8 * c) = o; }
    asm volatile("s_waitcnt lgkmcnt(0)" ::: "memory");
}

__device__ __forceinline__ void convert_flat(gcfp  src, gbp  dst, size_t n, size_t gtid, size_t gthreads) {
    for (size_t i = gtid * 8; i < n; i += gthreads * 8) {
        const f32x4 a = *(GAS const f32x4*)(src + i), b = *(GAS const f32x4*)(src + i + 4);
        u32x4 o; o.x = pk2(a.x, a.y); o.y = pk2(a.z, a.w); o.z = pk2(b.x, b.y); o.w = pk2(b.z, b.w);
        *(GAS u32x4*)(dst + i) = o;
    }
}

__device__ void s5_constants(const KP& p, int gtid);
__device__ __forceinline__ void tile_publish(GAS unsigned* flags, int tile, int wid);
#define XB_TILE(p, tile) ((gbp)((p).ws + WS_Z + (size_t)(tile) * TILE * 1536 * 2))
constexpr int P0_WB = 148, P0_SPLIT = (NTILES - P0_WB) * NW * 64;
__device__ void phase0(const KP& p, LAS unsigned char* lds, int tid, int lane, int wid) {
    gucp  ws = p.ws;
    const int gw = blockIdx.x * NW + wid, NGW = gridDim.x * NW;
    LAS float* scr = (LAS float*)(lds + wid * 16384);
    if (blockIdx.x < P0_WB && blockIdx.x >= 24 && blockIdx.x < 88) {
        const int it = blockIdx.x * 2 + (wid >> 2), kq = wid & 3;
        const int fi = it - 48, layer = fi >> 6, nb = fi & 63, hh = nb >> 3, cc = (nb >> 2) & 1, kblk = nb & 3, n0 = nb * 32;
        const int lr = lane & 31, lh = lane >> 5;
        gcfp Wq = p.in[23] + (size_t)layer * 1024 * 2048 + hh * 256 + cc * 128 + lh * 8;
        gcfp Kk = p.in[24] + ((size_t)((layer * 8 + hh) * 2 + cc) * 128 + kblk * 32 + lr) * 128 + lh * 8;
        gucp WT = ws + WS_WQ8 + (size_t)layer * 2048 * 1024; gfp SC = (gfp)(ws + WS_WSC) + WSC_WQ + layer * 2048;
        LAS float* pm = (LAS float*)(lds + 131072);
        bf16x8 kf[8];
#pragma unroll
        for (int ks = 0; ks < 8; ++ks) { const f32x4 a = *(GAS const f32x4*)(Kk + ks * 16), b = *(GAS const f32x4*)(Kk + ks * 16 + 4);
            u32x4 o; o.x = pk2(a.x, a.y); o.y = pk2(a.z, a.w); o.z = pk2(b.x, b.y); o.w = pk2(b.z, b.w); kf[ks] = __builtin_bit_cast(bf16x8, o); }
        f32x16 facc[8];
#pragma unroll
        for (int mf = 0; mf < 8; ++mf) {
#pragma unroll
            for (int i = 0; i < 16; ++i) facc[mf][i] = 0.f;
            gcfp wrow = Wq + (size_t)(256 * kq + mf * 32 + lr) * 2048;
#pragma unroll
            for (int k4 = 0; k4 < 8; k4 += 4) {
                f32x4 wa[4][2];
#pragma unroll
                for (int ks = 0; ks < 4; ++ks) { wa[ks][0] = *(GAS const f32x4*)(wrow + (k4 + ks) * 16); wa[ks][1] = *(GAS const f32x4*)(wrow + (k4 + ks) * 16 + 4); }
#pragma unroll
                for (int ks = 0; ks < 4; ++ks) { u32x4 o; o.x = pk2(wa[ks][0].x, wa[ks][0].y); o.y = pk2(wa[ks][0].z, wa[ks][0].w); o.z = pk2(wa[ks][1].x, wa[ks][1].y); o.w = pk2(wa[ks][1].z, wa[ks][1].w);
                    facc[mf] = __builtin_amdgcn_mfma_f32_32x32x16_bf16(__builtin_bit_cast(bf16x8, o), kf[k4 + ks], facc[mf], 0, 0, 0); }
            }
        }
        float m = 0.f;
#pragma unroll
        for (int mf = 0; mf < 8; ++mf)
#pragma unroll
            for (int i = 0; i < 16; ++i) m = fmaxf(m, fabsf(facc[mf][i]));
        m = wave_max_dpp(m);
        if (lane == 0) pm[wid] = m;
        __syncthreads();
        { const int w0 = wid & ~3; m = fmaxf(fmaxf(pm[w0], pm[w0 + 1]), fmaxf(pm[w0 + 2], pm[w0 + 3])); }
        const float scale = fmaxf(m, 1e-30f) * (1.0f / 127.0f), rs = 1.0f / scale;
        if (kq == 0 && lane < 32) SC[n0 + lane] = scale;
#pragma unroll
        for (int kb2 = 0; kb2 < 4; ++kb2) {
#pragma unroll
            for (int f = 0; f < 2; ++f)
#pragma unroll
                for (int i = 0; i < 16; ++i) scr[(f * 32 + (i & 3) + 8 * (i >> 2) + 4 * lh) * 33 + lr] = facc[2 * kb2 + f][i];
            asm volatile("s_waitcnt lgkmcnt(0)" ::: "memory");
            const int n = lane >> 1, kh = (lane & 1) * 32; u32x4 o[2];
#pragma unroll
            for (int q = 0; q < 8; ++q) { unsigned w = 0;
#pragma unroll
                for (int e = 0; e < 4; ++e) { const int qv = (int)rintf(scr[(kh + 4 * q + e) * 33 + n] * rs); w |= (unsigned)(qv & 0xff) << (8 * e); }
                o[q >> 2][q & 3] = w; }
            gucp dst = WT + (size_t)(n0 + n) * 1024 + (4 * kq + kb2) * 64 + kh;
            *(GAS u32x4*)dst = o[0]; *(GAS u32x4*)(dst + 16) = o[1];
            asm volatile("s_waitcnt lgkmcnt(0)" ::: "memory");
        }
    } else if (blockIdx.x < P0_WB) {
        const int it = blockIdx.x * 2 + (wid >> 2), kq = wid & 3;
        gcfp W; int N, n0, K = 1024; gucp WT; gfp SC;
        int ns = -1;
        if (it < 48) { W = p.in[4]; N = 1536; n0 = it * 32; WT = ws + WS_WIN8; SC = (gfp)(ws + WS_WSC) + WSC_WIN;
            if (it >= 16) { const int r0 = it * 32 - 512, t2 = r0 >> 8, c0 = r0 & 255; ns = (((c0 >> 5) & 1) ? 1024 : 512) + t2 * 128 + (c0 >> 6) * 32; } }
        else if (it < 216) { W = p.in[19]; N = 1280; n0 = (it - 176) * 32; WT = ws + WS_WQKV8; SC = (gfp)(ws + WS_WSC) + WSC_WQKV; }
        else if (it < 248) { W = p.in[18]; N = 1024; n0 = (it - 216) * 32; WT = ws + WS_WOUT; SC = (gfp)(ws + WS_WSC) + WSC_WOUT; }
        else if (it < 280) { W = p.in[22]; N = 1024; n0 = (it - 248) * 32; WT = ws + WS_WO; SC = (gfp)(ws + WS_WSC) + WSC_WO; }
        else { W = p.in[13]; N = 512; K = 512; n0 = (it - 280) * 32; WT = ws + WS_WGLU; SC = (gfp)(ws + WS_WSC) + WSC_WGLU; }
        if (ns < 0) ns = n0;
        const int kbq = K >> 8;
        LAS float* pm = (LAS float*)(lds + 131072);
        float m = 0.f;
#pragma unroll 2
        for (int kb = kbq * kq; kb < kbq * kq + kbq; ++kb)
#pragma unroll 8
            for (int i = 0; i < 32; ++i) m = fmaxf(m, fabsf(W[(size_t)(kb * 64 + 2 * i + (lane >> 5)) * N + ns + (lane & 31)]));
        m = fmaxf(m, __shfl_xor(m, 32));
        if (lane < 32) pm[wid * 32 + lane] = m;
        __syncthreads();
        { const int w0 = wid & ~3, c = lane & 31; m = fmaxf(fmaxf(pm[w0 * 32 + c], pm[(w0 + 1) * 32 + c]), fmaxf(pm[(w0 + 2) * 32 + c], pm[(w0 + 3) * 32 + c])); }
        const float scale = fmaxf(m, 1e-30f) * (1.0f / 127.0f);
        if (kq == 0 && lane < 32) SC[n0 + lane] = scale;
        const float rs_own = 1.0f / scale;
        const float rs = __shfl(rs_own, lane >> 1);
        for (int kb = kbq * kq; kb < kbq * kq + kbq; ++kb) {
#pragma unroll 8
            for (int i = 0; i < 32; ++i) { const int kk = 2 * i + (lane >> 5); scr[kk * 33 + (lane & 31)] = W[(size_t)(kb * 64 + kk) * N + ns + (lane & 31)]; }
            asm volatile("s_waitcnt lgkmcnt(0)" ::: "memory");
            const int n = lane >> 1, kh = (lane & 1) * 32; u32x4 o[2];
#pragma unroll
            for (int q = 0; q < 8; ++q) { unsigned w = 0;
#pragma unroll
                for (int e = 0; e < 4; ++e) { const int qv = (int)rintf(scr[(kh + 4 * q + e) * 33 + n] * rs); w |= (unsigned)(qv & 0xff) << (8 * e); }
                o[q >> 2][q & 3] = w; }
            gucp dst = WT + (size_t)(n0 + n) * K + kb * 64 + kh;
            *(GAS u32x4*)dst = o[0]; *(GAS u32x4*)(dst + 16) = o[1];
            asm volatile("s_waitcnt lgkmcnt(0)" ::: "memory");
        }
    }
    const size_t gtid = (size_t)blockIdx.x * NT + tid, gthreads = (size_t)gridDim.x * NT;
    s5_constants(p, (int)gtid);
    if (blockIdx.x < 24) tile_publish((GAS unsigned*)(ws + WS_CTL) + 1024, (int)blockIdx.x, wid);
    for (size_t idx = gtid; idx < (size_t)SEQ * 8; idx += gthreads) {
        const int pos = (int)(idx >> 3), i = (int)(idx & 7);
        const float inv = __builtin_powf(500000.0f, -(float)i * 0.125f);
        float sn, cn; sincosf((float)pos * inv, &sn, &cn);
        typedef float f32x2r __attribute__((ext_vector_type(2)));
        ((GAS f32x2r*)(ws + WS_ROPE))[idx] = (f32x2r){cn, sn};
    }
    const bool wb = blockIdx.x < P0_WB;
    const int TNGW = wb ? P0_WB * NW : ((int)gridDim.x - P0_WB) * NW, tgw = (wb ? (int)blockIdx.x : (int)blockIdx.x - P0_WB) * NW + wid;
    const int rbeg = wb ? P0_SPLIT : 0, rend = wb ? 2 * 2 * 16384 : P0_SPLIT;
#pragma unroll 1
    for (int row0 = rbeg + tgw; row0 < rend; row0 += 4 * TNGW) {
        f32x4 v[4][4]; float m[4];
#pragma unroll
        for (int i = 0; i < 4; ++i) { const int row = min(row0 + i * TNGW, rend - 1), isv = row >= 2 * 16384, rr = isv ? row - 2 * 16384 : row;
            gcfp srcr = (isv ? p.in[26] : p.in[25]) + (size_t)rr * 1024 + 16 * lane;
#pragma unroll
            for (int j = 0; j < 4; ++j) v[i][j] = *(GAS const f32x4*)(srcr + 4 * j); }
#pragma unroll
        for (int i = 0; i < 4; ++i) { m[i] = 0.f;
#pragma unroll
            for (int j = 0; j < 4; ++j) m[i] = fmaxf(m[i], fmaxf(fmaxf(fabsf(v[i][j].x), fabsf(v[i][j].y)), fmaxf(fabsf(v[i][j].z), fabsf(v[i][j].w)))); }
#pragma unroll
        for (int i = 0; i < 4; ++i) m[i] = wave_max_dpp(m[i]);
#pragma unroll
        for (int i = 0; i < 4; ++i) { const int row = row0 + i * TNGW; if (row >= rend) continue;
            const int isv = row >= 2 * 16384, rr = isv ? row - 2 * 16384 : row;
            if (!isv) {
                const float sc4 = fmaxf(m[i], 1e-30f) * (0.76f / 7.0f), rs4 = 1.0f / sc4;
                unsigned w4[2] = {0u, 0u};
#pragma unroll
                for (int j = 0; j < 4; ++j) {
                    const unsigned n0 = (unsigned)((int)fminf(fmaxf(rintf(v[i][j].x * rs4), -7.f), 7.f) & 15), n1 = (unsigned)((int)fminf(fmaxf(rintf(v[i][j].y * rs4), -7.f), 7.f) & 15), n2 = (unsigned)((int)fminf(fmaxf(rintf(v[i][j].z * rs4), -7.f), 7.f) & 15), n3 = (unsigned)((int)fminf(fmaxf(rintf(v[i][j].w * rs4), -7.f), 7.f) & 15);
                    w4[j >> 1] |= (n0 | (n1 << 4) | (n2 << 8) | (n3 << 12)) << (16 * (j & 1));
                }
                *(GAS u32x2*)(ws + WS_PU + (size_t)rr * 512 + 8 * lane) = (u32x2){w4[0], w4[1]};
                if (lane == 0) ((gfp)(ws + WS_SU))[rr] = sc4;
                continue;
            }
            const float scale = fmaxf(m[i], 1e-30f) * (1.0f / 127.0f), rs = 1.0f / scale;
            const int off = isv ? 128 : 0;
            u32x4 o4;
#pragma unroll
            for (int j = 0; j < 4; ++j) {
                const int q0 = (int)rintf(v[i][j].x * rs) + off, q1 = (int)rintf(v[i][j].y * rs) + off, q2 = (int)rintf(v[i][j].z * rs) + off, q3 = (int)rintf(v[i][j].w * rs) + off;
                o4[j] = (unsigned)(q0 & 0xff) | ((unsigned)(q1 & 0xff) << 8) | ((unsigned)(q2 & 0xff) << 16) | ((unsigned)(q3 & 0xff) << 24);
            }
            *(GAS u32x4*)(ws + (isv ? WS_PV : WS_PU) + (size_t)rr * 1024 + 16 * lane) = o4;
            if (lane == 0) ((gfp)(ws + (isv ? WS_SV : WS_SU)))[rr] = scale;
        }
    }
}


constexpr size_t S5_ABAR = 0, S5_A128 = 16384, S5_BBAR = 32768, S5_CMAT = 163840;
__device__ void s5_constants(const KP& p, int gtid) {
    if (gtid >= 2048) return;
    const int g = gtid >> 6, pp = gtid & 63;
    gucp  base = p.ws + WS_S5;
    const double lre = (double)p.in[5][gtid], lim = (double)p.in[6][gtid];
    const double dt = exp((double)p.in[7][g]);
    const double mag = exp(lre * dt), ar = mag * cos(lim * dt), ai = mag * sin(lim * dt);
    ((gfp)(base + S5_ABAR))[gtid * 2 + 0] = (float)ar; ((gfp)(base + S5_ABAR))[gtid * 2 + 1] = (float)ai;
    double pr = ar, pi = ai;
    for (int i = 0; i < 7; ++i) { const double nr = pr * pr - pi * pi, ni = 2.0 * pr * pi; pr = nr; pi = ni; }
    ((gfp)(base + S5_A128))[gtid * 2 + 0] = (float)pr; ((gfp)(base + S5_A128))[gtid * 2 + 1] = (float)pi;
    const double den = lre * lre + lim * lim, nr_ = ar - 1.0, ni_ = ai;
    const double cr = (nr_ * lre + ni_ * lim) / den, ci = (ni_ * lre - nr_ * lim) / den;
    gbp  bb = (gbp)(base + S5_BBAR);
    for (int h = 0; h < 16; ++h) {
        const double br = (double)p.in[8][(size_t)gtid * 16 + h], bi = (double)p.in[9][(size_t)gtid * 16 + h];
        bb[((g * 2 + 0) * 64 + pp) * 16 + h] = (bf16)f2bf((float)(cr * br - ci * bi));
        bb[((g * 2 + 1) * 64 + pp) * 16 + h] = (bf16)f2bf((float)(cr * bi + ci * br));
    }
    gbp  cm = (gbp)(base + S5_CMAT);
    for (int h = 0; h < 16; ++h) {
        cm[(g * 16 + h) * 128 + pp] = (bf16)f2bf(p.in[10][(size_t)(g * 16 + h) * 64 + pp]);
        cm[(g * 16 + h) * 128 + 64 + pp] = (bf16)f2bf(-p.in[11][(size_t)(g * 16 + h) * 64 + pp]);
    }
}

__device__ __forceinline__ void rmsnorm_row_bf16(gcfp  xrow, gcfp  g, gbp  orow, int lane) {
    f32x4 v[4]; float s = 0.f;
#pragma unroll
    for (int j = 0; j < 4; ++j) { v[j] = *(GAS const f32x4*)(xrow + 4 * lane + 256 * j); s += (v[j].x * v[j].x + v[j].y * v[j].y) + (v[j].z * v[j].z + v[j].w * v[j].w); }
    const float rstd = 1.0f / sqrtf(wave_sum(s) * (1.0f / D) + EPS);
#pragma unroll
    for (int j = 0; j < 4; ++j) { const f32x4 gg = *(GAS const f32x4*)(g + 4 * lane + 256 * j); const f32x4 o = v[j] * rstd * gg;
        u32x2 w; w.x = pk2(o.x, o.y); w.y = pk2(o.z, o.w); *(GAS u32x2*)(orow + 4 * lane + 256 * j) = w; }
}

template <int R>
__device__ __forceinline__ void rmsnorm_rows_q8(gcfp x0, gcfp g, gucp xq0, gfp sx0, int lane) {
    f32x4 v[R][4]; float s[R], m[R];
#pragma unroll
    for (int i = 0; i < R; ++i)
#pragma unroll
        for (int j = 0; j < 4; ++j) v[i][j] = *(GAS const f32x4*)(x0 + (size_t)i * 8 * D + 4 * lane + 256 * j);
    f32x4 gg[4];
#pragma unroll
    for (int j = 0; j < 4; ++j) gg[j] = *(GAS const f32x4*)(g + 4 * lane + 256 * j);
#pragma unroll
    for (int i = 0; i < R; ++i) { s[i] = 0.f;
#pragma unroll
        for (int j = 0; j < 4; ++j) s[i] += (v[i][j].x * v[i][j].x + v[i][j].y * v[i][j].y) + (v[i][j].z * v[i][j].z + v[i][j].w * v[i][j].w); }
#pragma unroll
    for (int i = 0; i < R; ++i) s[i] = wave_sum_dpp(s[i]);
#pragma unroll
    for (int i = 0; i < R; ++i) { const float rstd = 1.0f / sqrtf(s[i] * (1.0f / D) + EPS); m[i] = 0.f;
#pragma unroll
        for (int j = 0; j < 4; ++j) { v[i][j] = v[i][j] * rstd * gg[j];
            m[i] = fmaxf(m[i], fmaxf(fmaxf(fabsf(v[i][j].x), fabsf(v[i][j].y)), fmaxf(fabsf(v[i][j].z), fabsf(v[i][j].w)))); } }
#pragma unroll
    for (int i = 0; i < R; ++i) m[i] = wave_max_dpp(m[i]);
#pragma unroll
    for (int i = 0; i < R; ++i) {
        const float scale = fmaxf(m[i], 1e-30f) * (1.0f / 127.0f), rs = 1.0f / scale;
        GAS unsigned* xq = (GAS unsigned*)(xq0 + (size_t)i * 8 * 1024);
#pragma unroll
        for (int j = 0; j < 4; ++j) { const int q0 = (int)rintf(v[i][j].x * rs), q1 = (int)rintf(v[i][j].y * rs), q2 = (int)rintf(v[i][j].z * rs), q3 = (int)rintf(v[i][j].w * rs);
            xq[lane + 64 * j] = (unsigned)(q0 & 0xff) | ((unsigned)(q1 & 0xff) << 8) | ((unsigned)(q2 & 0xff) << 16) | ((unsigned)(q3 & 0xff) << 24); }
        if (lane == 0) sx0[i * 8] = scale;
    }
}
__device__ __forceinline__ void rmsnorm_tile_q8(gcfp xt, gcfp g, gucp xqt, gfp sxt, int wid, int lane) {
#pragma unroll 1
    for (int r = wid; r < TILE; r += 4 * NW) rmsnorm_rows_q8<4>(xt + (size_t)r * D, g, xqt + (size_t)r * 1024, sxt + r, lane);
}

template <int R>
__device__ __forceinline__ void rmsnorm_rows_q8_bf(gcbp x0, gcfp g, gucp xq0, gfp sx0, int lane, float qinv) {
    f32x4 v[R][4]; float s[R], m[R];
#pragma unroll
    for (int i = 0; i < R; ++i)
#pragma unroll
        for (int j = 0; j < 4; ++j) { const u32x2q w = *(GAS const u32x2q*)(x0 + (size_t)i * 8 * D + 4 * lane + 256 * j);
            v[i][j] = (f32x4){__uint_as_float(w.x << 16), __uint_as_float(w.x & 0xffff0000u), __uint_as_float(w.y << 16), __uint_as_float(w.y & 0xffff0000u)}; }
    f32x4 gg[4];
#pragma unroll
    for (int j = 0; j < 4; ++j) gg[j] = *(GAS const f32x4*)(g + 4 * lane + 256 * j);
#pragma unroll
    for (int i = 0; i < R; ++i) { s[i] = 0.f;
#pragma unroll
        for (int j = 0; j < 4; ++j) s[i] += (v[i][j].x * v[i][j].x + v[i][j].y * v[i][j].y) + (v[i][j].z * v[i][j].z + v[i][j].w * v[i][j].w); }
#pragma unroll
    for (int i = 0; i < R; ++i) s[i] = wave_sum_dpp(s[i]);
#pragma unroll
    for (int i = 0; i < R; ++i) { const float rstd = 1.0f / sqrtf(s[i] * (1.0f / D) + EPS); m[i] = 0.f;
#pragma unroll
        for (int j = 0; j < 4; ++j) { v[i][j] = v[i][j] * rstd * gg[j];
            m[i] = fmaxf(m[i], fmaxf(fmaxf(fabsf(v[i][j].x), fabsf(v[i][j].y)), fmaxf(fabsf(v[i][j].z), fabsf(v[i][j].w)))); } }
#pragma unroll
    for (int i = 0; i < R; ++i) m[i] = wave_max_dpp(m[i]);
#pragma unroll
    for (int i = 0; i < R; ++i) {
        const float scale = fmaxf(m[i], 1e-30f) * qinv, rs = 1.0f / scale;
        GAS unsigned* xq = (GAS unsigned*)(xq0 + (size_t)i * 8 * 1024);
#pragma unroll
        for (int j = 0; j < 4; ++j) { const int q0 = (int)rintf(v[i][j].x * rs), q1 = (int)rintf(v[i][j].y * rs), q2 = (int)rintf(v[i][j].z * rs), q3 = (int)rintf(v[i][j].w * rs);
            xq[lane + 64 * j] = (unsigned)(q0 & 0xff) | ((unsigned)(q1 & 0xff) << 8) | ((unsigned)(q2 & 0xff) << 16) | ((unsigned)(q3 & 0xff) << 24); }
        if (lane == 0) sx0[i * 8] = scale;
    }
}
__device__ __forceinline__ void rmsnorm_tile_q8_bf(gcbp xt, gcfp g, gucp xqt, gfp sxt, int wid, int lane, float qinv) {
#pragma unroll 1
    for (int r = wid; r < TILE; r += 8 * NW) rmsnorm_rows_q8_bf<8>(xt + (size_t)r * D, g, xqt + (size_t)r * 1024, sxt + r, lane, qinv);
}
template <int R, int K>
__device__ __forceinline__ void quant_rows_bf16(gcbp a0, int lda, gucp xq0, gfp sx0, int lane) {
    constexpr int C = K / 512;
    u32x4 v[R][C]; float m[R];
#pragma unroll
    for (int i = 0; i < R; ++i)
#pragma unroll
        for (int c = 0; c < C; ++c) v[i][c] = *(GAS const u32x4*)(a0 + (size_t)i * 8 * lda + 8 * lane + 512 * c);
#pragma unroll
    for (int i = 0; i < R; ++i) { m[i] = 0.f;
#pragma unroll
        for (int c = 0; c < C; ++c)
#pragma unroll
            for (int e = 0; e < 4; ++e) { const unsigned w = v[i][c][e]; m[i] = fmaxf(m[i], fmaxf(fabsf(__uint_as_float(w << 16)), fabsf(__uint_as_float(w & 0xffff0000u)))); } }
#pragma unroll
    for (int i = 0; i < R; ++i) m[i] = wave_max_dpp(m[i]);
#pragma unroll
    for (int i = 0; i < R; ++i) {
        const float scale = fmaxf(m[i], 1e-30f) * (1.0f / 127.0f), rs = 1.0f / scale;
#pragma unroll
        for (int c = 0; c < C; ++c) { u32x2q o;
#pragma unroll
            for (int h = 0; h < 2; ++h) { const unsigned w0 = v[i][c][2 * h], w1 = v[i][c][2 * h + 1];
                const int q0 = (int)rintf(__uint_as_float(w0 << 16) * rs), q1 = (int)rintf(__uint_as_float(w0 & 0xffff0000u) * rs), q2 = (int)rintf(__uint_as_float(w1 << 16) * rs), q3 = (int)rintf(__uint_as_float(w1 & 0xffff0000u) * rs);
                o[h] = (unsigned)(q0 & 0xff) | ((unsigned)(q1 & 0xff) << 8) | ((unsigned)(q2 & 0xff) << 16) | ((unsigned)(q3 & 0xff) << 24); }
            *(GAS u32x2q*)(xq0 + (size_t)i * 8 * 1024 + 8 * lane + 512 * c) = o; }
        if (lane == 0) sx0[i * 8] = scale;
    }
}
template <int K>
__device__ __forceinline__ void quant_tile_bf16(gcbp at, int lda, gucp xqt, gfp sxt, int wid, int lane) {
#pragma unroll 1
    for (int r = wid; r < TILE; r += 8 * NW) quant_rows_bf16<8, K>(at + (size_t)r * lda, lda, xqt + (size_t)r * 1024, sxt + r, lane);
}

constexpr int G_STAGE = 49152;
typedef int i32x4v __attribute__((ext_vector_type(4)));
typedef int i32x16 __attribute__((ext_vector_type(16)));
__device__ __forceinline__ void gemm_issue(LAS unsigned char* lds, int s, gcucp A, int lda, gcucp Bt, int ldb, int kt, int wid, int lane) {
    const int r8 = lane >> 3, c8 = lane & 7;
#pragma unroll
    for (int i = 0; i < 2; ++i) { const int pc = wid + 8 * i, row = 8 * pc + r8, c = c8 ^ ((row >> 1) & 7);
        __builtin_amdgcn_global_load_lds((GAS const unsigned*)(A + (size_t)row * lda + kt * 128 + c * 16), (LAS unsigned*)(lds + s * G_STAGE + pc * 1024), 16, 0, 0); }
#pragma unroll
    for (int i = 0; i < 4; ++i) { const int pc = wid + 8 * i, row = 8 * pc + r8, c = c8 ^ ((row >> 1) & 7);
        __builtin_amdgcn_global_load_lds((GAS const unsigned*)(Bt + (size_t)row * ldb + kt * 128 + c * 16), (LAS unsigned*)(lds + s * G_STAGE + 16384 + pc * 1024), 16, 0, 0); }
}
__device__ __forceinline__ void gemm_tile_bytes(LAS unsigned char* lds, gcucp A, int lda, gcucp Bt, int ldb, int Kbytes, f32x16 (&acc)[2][2], int wid, int lane) {
    const int wr = wid >> 2, wc = wid & 3, lr = lane & 31, lh = lane >> 5, nk = Kbytes / 128;
#pragma unroll
    for (int m = 0; m < 2; ++m)
#pragma unroll
        for (int n = 0; n < 2; ++n)
#pragma unroll
            for (int i = 0; i < 16; ++i) acc[m][n][i] = 0.f;
    __syncthreads();
    gemm_issue(lds, 0, A, lda, Bt, ldb, 0, wid, lane);
    for (int kt = 0; kt < nk; ++kt) {
        const int s = kt & 1;
        asm volatile("s_waitcnt vmcnt(0)" ::: "memory");
        __syncthreads();
        if (kt + 1 < nk) gemm_issue(lds, s ^ 1, A, lda, Bt, ldb, kt + 1, wid, lane);
        LAS unsigned char* sa = lds + s * G_STAGE; LAS unsigned char* sb = sa + 16384;
#pragma unroll
        for (int ks = 0; ks < 4; ++ks) {
            bf16x8 a[2], b[2];
#pragma unroll
            for (int m = 0; m < 2; ++m) { const int row = wr * 64 + m * 32 + lr, c = (2 * ks + lh) ^ ((row >> 1) & 7); a[m] = *(const LAS bf16x8*)(sa + row * 128 + c * 16); }
#pragma unroll
            for (int n = 0; n < 2; ++n) { const int row = wc * 64 + n * 32 + lr, c = (2 * ks + lh) ^ ((row >> 1) & 7); b[n] = *(const LAS bf16x8*)(sb + row * 128 + c * 16); }
#pragma unroll
            for (int m = 0; m < 2; ++m)
#pragma unroll
                for (int n = 0; n < 2; ++n) acc[m][n] = __builtin_amdgcn_mfma_f32_32x32x16_bf16(a[m], b[n], acc[m][n], 0, 0, 0);
        }
    }
}
__device__ __forceinline__ void gemm_tile_i8(LAS unsigned char* lds, gcucp A, int lda, gcucp Bt, int ldb, int Kbytes, i32x16 (&acc)[2][2], int wid, int lane) {
    const int wr = wid >> 2, wc = wid & 3, lr = lane & 31, lh = lane >> 5, nk = Kbytes / 128;
#pragma unroll
    for (int m = 0; m < 2; ++m)
#pragma unroll
        for (int n = 0; n < 2; ++n)
#pragma unroll
            for (int i = 0; i < 16; ++i) acc[m][n][i] = 0;
    __syncthreads();
    gemm_issue(lds, 0, A, lda, Bt, ldb, 0, wid, lane);
    if (nk > 1) gemm_issue(lds, 1, A, lda, Bt, ldb, 1, wid, lane);
#pragma unroll 1
    for (int kt = 0, s = 0; kt < nk; ++kt, s = (s == 2 ? 0 : s + 1)) {
        if (kt + 1 < nk) asm volatile("s_waitcnt vmcnt(6)" ::: "memory"); else asm volatile("s_waitcnt vmcnt(0)" ::: "memory");
        asm volatile("s_waitcnt lgkmcnt(0)" ::: "memory");
        __builtin_amdgcn_s_barrier();
        asm volatile("" ::: "memory");
        if (kt + 2 < nk) gemm_issue(lds, (s == 0 ? 2 : s - 1), A, lda, Bt, ldb, kt + 2, wid, lane);
        LAS unsigned char* sa = lds + s * G_STAGE; LAS unsigned char* sb = sa + 16384;
#pragma unroll
        for (int ks = 0; ks < 4; ++ks) {
            i32x4v a[2], b[2];
#pragma unroll
            for (int m = 0; m < 2; ++m) { const int row = wr * 64 + m * 32 + lr, c = (2 * ks + lh) ^ ((row >> 1) & 7); a[m] = *(const LAS i32x4v*)(sa + row * 128 + c * 16); }
#pragma unroll
            for (int n = 0; n < 2; ++n) { const int row = wc * 64 + n * 32 + lr, c = (2 * ks + lh) ^ ((row >> 1) & 7); b[n] = *(const LAS i32x4v*)(sb + row * 128 + c * 16); }
#pragma unroll
            for (int m = 0; m < 2; ++m)
#pragma unroll
                for (int n = 0; n < 2; ++n) acc[m][n] = __builtin_amdgcn_mfma_i32_32x32x32_i8(a[m], b[n], acc[m][n], 0, 0, 0);
        }
    }
}
__device__ __forceinline__ void gemm_scores_i8(LAS unsigned char* lds, gcucp A, int lda, gcucp Bt, int ldb, int Kbytes, i32x16 (&acc)[4], int wid, int lane) {
    const int c = wid >> 2, tg = wid & 3, lr = lane & 31, lh = lane >> 5, nk = Kbytes / 128;
#pragma unroll
    for (int m = 0; m < 4; ++m)
#pragma unroll
        for (int i = 0; i < 16; ++i) acc[m][i] = 0;
    __syncthreads();
    gemm_issue(lds, 0, A, lda, Bt, ldb, 0, wid, lane);
    if (nk > 1) gemm_issue(lds, 1, A, lda, Bt, ldb, 1, wid, lane);
#pragma unroll 1
    for (int kt = 0, s = 0; kt < nk; ++kt, s = (s == 2 ? 0 : s + 1)) {
        if (kt + 1 < nk) asm volatile("s_waitcnt vmcnt(6)" ::: "memory"); else asm volatile("s_waitcnt vmcnt(0)" ::: "memory");
        asm volatile("s_waitcnt lgkmcnt(0)" ::: "memory");
        __builtin_amdgcn_s_barrier();
        asm volatile("" ::: "memory");
        if (kt + 2 < nk) gemm_issue(lds, (s == 0 ? 2 : s - 1), A, lda, Bt, ldb, kt + 2, wid, lane);
        LAS unsigned char* sa = lds + s * G_STAGE; LAS unsigned char* sb = sa + 16384;
#pragma unroll
        for (int ks = 0; ks < 4; ++ks) {
            i32x4v w[4], t;
            { const int row = tg * 32 + lr, ch = (2 * ks + lh) ^ ((row >> 1) & 7); t = *(const LAS i32x4v*)(sa + row * 128 + ch * 16); }
#pragma unroll
            for (int m = 0; m < 4; ++m) { const int row = c * 128 + m * 32 + lr, ch = (2 * ks + lh) ^ ((row >> 1) & 7); w[m] = *(const LAS i32x4v*)(sb + row * 128 + ch * 16); }
#pragma unroll
            for (int m = 0; m < 4; ++m) acc[m] = __builtin_amdgcn_mfma_i32_32x32x32_i8(w[m], t, acc[m], 0, 0, 0);
        }
    }
}
__device__ __forceinline__ void gemm_tile(LAS unsigned char* lds, gcbp A, int lda, gcbp Bt, int ldb, int K, f32x16 (&acc)[2][2], int wid, int lane) {
    gemm_tile_bytes(lds, (gcucp)A, lda * 2, (gcucp)Bt, ldb * 2, K * 2, acc, wid, lane);
}
#define OPAQUE_S(x) asm volatile("" : "+s"(x))
#define OPAQUE_V(x) asm volatile("" : "+v"(x))
template <class P> __device__ __forceinline__ P launder(P p) { asm volatile("" : "+v"(p)); return p; }
#define GEMM_RB(wid, lane) (((wid) >> 2) * 64 + 4 * ((lane) >> 5))
#define GEMM_CB(wid, lane) (((wid) & 3) * 64 + ((lane) & 31))
#define FR_ROW(i) (((i) & 3) + 8 * ((i) >> 2))
struct EpiSc { f32x4 rs[2][4]; float cs[2]; };
__device__ __forceinline__ void load_episc(EpiSc& e, gcfp sx_tile, gcfp sw_cols, int wid, int lane) {
    gcfp s = sx_tile + GEMM_RB(wid, lane);
#pragma unroll
    for (int m = 0; m < 2; ++m)
#pragma unroll
        for (int q = 0; q < 4; ++q) e.rs[m][q] = *(GAS const f32x4*)(s + 32 * m + 8 * q);
#pragma unroll
    for (int n = 0; n < 2; ++n) e.cs[n] = sw_cols[GEMM_CB(wid, lane) + 32 * n];
}
#define EPI_SCALE(e, i) ((e).cs[_n] * (e).rs[_m][(i) >> 2][(i) & 3])
#define GEMM_FOR_FRAGS_I(acc, CODE) do { \
    _Pragma("unroll") for (int _m = 0; _m < 2; ++_m) _Pragma("unroll") for (int _n = 0; _n < 2; ++_n) { \
        const int fo_r = _m * 32, fo_c = _n * 32; const i32x16 fr = acc[_m][_n]; CODE \
        asm volatile("" ::: "memory"); } } while (0)
#define GEMM_FOR_FRAGS(acc, CODE) do { \
    _Pragma("unroll") for (int _m = 0; _m < 2; ++_m) _Pragma("unroll") for (int _n = 0; _n < 2; ++_n) { \
        const int fo_r = _m * 32, fo_c = _n * 32; const f32x16 fr = acc[_m][_n]; CODE \
        asm volatile("" ::: "memory"); } } while (0)

__device__ __forceinline__ float gelu_exact(float v) { return 0.5f * v * (1.0f + erff(v * 0.70710678118654752f)); }

__device__ __forceinline__ float gelu_fast(float v) {
    const float av = fabsf(v), t = __builtin_amdgcn_rcpf(av * 0.2316418882f + 1.0f);
    float q = t * 0.5307027145f + (-0.7265760135f); q = q * t + 0.7107068705f; q = q * t + (-0.142248368f); q = q * t + 0.127414796f; q = q * t;
    const float e = __builtin_amdgcn_exp2f((v * v) * (-0.72134752044f));
    const float m = v * (q * e);
    return v < 0.f ? m : v - m;
}
__device__ __forceinline__ unsigned cvt_pk_bf16(float lo, float hi) { unsigned r; asm volatile("v_cvt_pk_bf16_f32 %0, %1, %2" : "=v"(r) : "v"(lo), "v"(hi)); return r; }
__device__ __forceinline__ unsigned f2bf_hw(float f) { return cvt_pk_bf16(f, f) & 0xffffu; }
__device__ __forceinline__ float xchg32(float x, int lh) {
    auto s = __builtin_amdgcn_permlane32_swap(__float_as_uint(x), __float_as_uint(x), false, false);
    return __uint_as_float(lh ? s[0] : s[1]);
}
struct CPow { float r[4], i[4]; };
__device__ __forceinline__ CPow cpowers(float ar, float ai) {
    CPow c; c.r[0] = ar; c.i[0] = ai;
    c.r[1] = ar * ar - ai * ai; c.i[1] = 2.f * ar * ai;
    c.r[2] = c.r[1] * ar - c.i[1] * ai; c.i[2] = c.r[1] * ai + c.i[1] * ar;
    c.r[3] = c.r[1] * c.r[1] - c.i[1] * c.i[1]; c.i[3] = 2.f * c.r[1] * c.i[1];
    return c;
}
__device__ __forceinline__ void s5_scan32(f32x16& re, f32x16& im, const CPow& A, float& sr, float& si, int lh) {
    const float ar = A.r[0], ai = A.i[0];
#pragma unroll
    for (int k = 0; k < 4; ++k) {
        if (lh == 0) {
#pragma unroll
            for (int j = 0; j < 4; ++j) { const float nr = ar * sr - ai * si + re[4 * k + j], ni = ar * si + ai * sr + im[4 * k + j]; sr = nr; si = ni; re[4 * k + j] = nr; im[4 * k + j] = ni; }
        }
        float tr = __shfl_xor(sr, 32), ti = __shfl_xor(si, 32);
        if (lh == 1) { sr = tr; si = ti;
#pragma unroll
            for (int j = 0; j < 4; ++j) { const float nr = ar * sr - ai * si + re[4 * k + j], ni = ar * si + ai * sr + im[4 * k + j]; sr = nr; si = ni; re[4 * k + j] = nr; im[4 * k + j] = ni; }
        }
        tr = __shfl_xor(sr, 32); ti = __shfl_xor(si, 32);
        if (lh == 0) { sr = tr; si = ti; }
    }
}

template <bool FINAL>
__device__ void s5_tile(const KP& p, LAS unsigned char* lds, int tile, int wid, int lane) {
    OPAQUE_S(tile); OPAQUE_V(lane);
    gcucp  cst = p.ws + WS_S5;
    gcbp  Z = (gcbp)(p.ws + WS_Z) + (size_t)tile * TILE * 1536;
    gfp  E = (gfp)(p.ws + WS_S5E);
    gbp  YS = (gbp)(p.ws + WS_PRIV + (size_t)tile * PRIV_BYTES + 262144);
    const int lr = lane & 31, lh = lane >> 5;
    LAS unsigned char* hl = lds + wid * 8704;
    typedef float f32x2 __attribute__((ext_vector_type(2)));
    float i0r[4], i0i[4], i1r[4], i1i[4];
#pragma unroll
    for (int gi = 0; gi < 4; ++gi) { i0r[gi] = 0.f; i0i[gi] = 0.f; i1r[gi] = 0.f; i1i[gi] = 0.f; }
    if (FINAL) {
        const int tl = tile % TILES_PER_SEQ, tb = tile - tl, m = tl >> 1;
        const int jb = lh ? m : 0, cnt = lh ? tl - m : m, cmax = tl - m;
        float qr[4][2], qi[4][2];
#pragma unroll
        for (int gi = 0; gi < 4; ++gi) { gcfp a128 = (gcfp)(cst + S5_A128) + (size_t)(wid * 4 + gi) * 128;
            qr[gi][0] = a128[lr * 2]; qi[gi][0] = a128[lr * 2 + 1]; qr[gi][1] = a128[(32 + lr) * 2]; qi[gi][1] = a128[(32 + lr) * 2 + 1]; }
#pragma unroll 1
        for (int j0 = 0; j0 < cmax; j0 += 4) {
            f32x2 e0[4][4], e1[4][4];
#pragma unroll
            for (int jj = 0; jj < 4; ++jj) { const int j = jb + min(j0 + jj, max(cnt - 1, 0));
#pragma unroll
                for (int gi = 0; gi < 4; ++gi) { gcfp e = E + ((size_t)(tb + j) * 32 + wid * 4 + gi) * 128;
                    e0[jj][gi] = *(GAS const f32x2*)(e + lr * 2); e1[jj][gi] = *(GAS const f32x2*)(e + (32 + lr) * 2); } }
#pragma unroll
            for (int jj = 0; jj < 4; ++jj) if (j0 + jj < cnt) {
#pragma unroll
                for (int gi = 0; gi < 4; ++gi) {
                    float nr = qr[gi][0] * i0r[gi] - qi[gi][0] * i0i[gi] + e0[jj][gi].x, ni = qr[gi][0] * i0i[gi] + qi[gi][0] * i0r[gi] + e0[jj][gi].y; i0r[gi] = nr; i0i[gi] = ni;
                    nr = qr[gi][1] * i1r[gi] - qi[gi][1] * i1i[gi] + e1[jj][gi].x; ni = qr[gi][1] * i1i[gi] + qi[gi][1] * i1r[gi] + e1[jj][gi].y; i1r[gi] = nr; i1i[gi] = ni;
                }
            }
        }
#pragma unroll
        for (int gi = 0; gi < 4; ++gi) {
#pragma unroll
            for (int c = 0; c < 2; ++c) {
                float hr = c ? i1r[gi] : i0r[gi], hi = c ? i1i[gi] : i0i[gi];
                float br = qr[gi][c], bi = qi[gi][c], pr = 1.f, pi = 0.f;
                for (int n = tl - m; n > 0; n >>= 1) { if (n & 1) { const float t = pr * br - pi * bi; pi = pr * bi + pi * br; pr = t; } const float t2 = br * br - bi * bi; bi = 2.f * br * bi; br = t2; }
                const float orr = xchg32(hr, lh), oi = xchg32(hi, lh);
                const float fr = pr * hr - pi * hi + orr, fi = pr * hi + pi * hr + oi;
                if (c) { i1r[gi] = fr; i1i[gi] = fi; } else { i0r[gi] = fr; i0i[gi] = fi; }
            }
        }
    }
#pragma unroll
    for (int gi = 0; gi < 4; ++gi) {
        const int g = wid * 4 + gi;
        bf16x8 bfr[4];
#pragma unroll
        for (int n = 0; n < 4; ++n) bfr[n] = *(GAS const bf16x8*)((gcbp)(cst + S5_BBAR) + ((g * 2 + (n >> 1)) * 64 + (n & 1) * 32 + lr) * 16 + lh * 8);
        gcfp  ab = (gcfp)(cst + S5_ABAR) + (size_t)g * 128;
        const CPow A0 = cpowers(ab[lr * 2], ab[lr * 2 + 1]), A1 = cpowers(ab[(32 + lr) * 2], ab[(32 + lr) * 2 + 1]);
        float s0r = i0r[gi], s0i = i0i[gi], s1r = i1r[gi], s1i = i1i[gi];
        bf16x8 cfr[4]; float dv = 0.f;
        if (FINAL) {
#pragma unroll
            for (int ks = 0; ks < 4; ++ks) cfr[ks] = *(GAS const bf16x8*)((gcbp)(cst + S5_CMAT) + (g * 16 + (lane & 15)) * 128 + ks * 32 + 8 * (lane >> 4));
            dv = p.in[12][g * 16 + (lane & 15)];
        }
        bf16x8 afr = *(GAS const bf16x8*)(Z + (size_t)lr * 1536 + g * 16 + lh * 8);
#pragma unroll 1
        for (int mf = 0; mf < 4; ++mf) {
            const bf16x8 acur = afr;
            if (mf < 3) afr = *(GAS const bf16x8*)(Z + (size_t)((mf + 1) * 32 + lr) * 1536 + g * 16 + lh * 8);
            bf16 uu[2][4];
            if (FINAL) {
#pragma unroll
                for (int mr = 0; mr < 2; ++mr)
#pragma unroll
                    for (int i = 0; i < 4; ++i) uu[mr][i] = Z[(size_t)(mf * 32 + mr * 16 + (lane >> 4) * 4 + i) * 1536 + g * 16 + (lane & 15)];
            }
            f32x16 acc[4];
#pragma unroll
            for (int n = 0; n < 4; ++n) {
#pragma unroll
                for (int i = 0; i < 16; ++i) acc[n][i] = 0.f;
                acc[n] = __builtin_amdgcn_mfma_f32_32x32x16_bf16(acur, bfr[n], acc[n], 0, 0, 0);
            }
            s5_scan32(acc[0], acc[2], A0, s0r, s0i, lh);
            s5_scan32(acc[1], acc[3], A1, s1r, s1i, lh);
            if (FINAL) {
#pragma unroll
                for (int n = 0; n < 4; ++n)
#pragma unroll
                    for (int i = 0; i < 16; i += 2) { const int t = (i & 3) + 8 * (i >> 2) + 4 * lh, k = (n >> 1) * 64 + (n & 1) * 32 + lr;
                        const unsigned pk = cvt_pk_bf16(acc[n][i], acc[n][i + 1]);
                        *(LAS bf16*)(hl + t * 272 + k * 2) = (bf16)(pk & 0xffffu); *(LAS bf16*)(hl + (t + 1) * 272 + k * 2) = (bf16)(pk >> 16); }
#pragma unroll
                for (int mr = 0; mr < 2; ++mr) {
                    f32x4 y4 = {0.f, 0.f, 0.f, 0.f};
#pragma unroll
                    for (int ks = 0; ks < 4; ++ks) { const bf16x8 ha = *(const LAS bf16x8*)(hl + (mr * 16 + (lane & 15)) * 272 + (ks * 32 + 8 * (lane >> 4)) * 2);
                        y4 = __builtin_amdgcn_mfma_f32_16x16x32_bf16(ha, cfr[ks], y4, 0, 0, 0); }
#pragma unroll
                    for (int i = 0; i < 4; i += 2) { const int t = mf * 32 + mr * 16 + (lane >> 4) * 4 + i, ch = g * 16 + (lane & 15);
                        const unsigned pk = cvt_pk_bf16(gelu_fast(y4[i] + dv * bf2f(uu[mr][i])), gelu_fast(y4[i + 1] + dv * bf2f(uu[mr][i + 1])));
                        YS[(size_t)t * 512 + ch] = (bf16)(pk & 0xffffu); YS[(size_t)(t + 1) * 512 + ch] = (bf16)(pk >> 16); }
                }
            }
        }
        if (!FINAL && lh == 0) {
            gfp  e = E + ((size_t)tile * 32 + g) * 128;
            e[lr * 2] = s0r; e[lr * 2 + 1] = s0i; e[(32 + lr) * 2] = s1r; e[(32 + lr) * 2 + 1] = s1i;
        }
    }
}

__device__ void conv_tile(const KP& p, LAS unsigned char* lds, int tile, int, int wid, int) {
    int lane = lane_id(); int tid = wid * 64 + lane; (void)tid;
    OPAQUE_S(tile); OPAQUE_V(lane); OPAQUE_V(tid);
    gcbp  Zall = (gcbp)(p.ws + WS_Z);
    gfp  YC = (gfp)(p.ws + WS_PRIV + (size_t)tile * PRIV_BYTES);
    gbp  ACT = (gbp)(p.ws + WS_ACT) + (size_t)tile * TILE * 1024;
    LAS float* vt = (LAS float*)lds;
    const bool first = (tile % TILES_PER_SEQ) == 0;
    const long row0 = (long)tile * TILE - 30;
    for (int cc = 0; cc < 4; ++cc) {
        __syncthreads();
        {
            u32x4 va5[5];
#pragma unroll
            for (int it = 0; it < 5; ++it) { const int idx = tid + it * NT, j = idx >> 4, q = idx & 15;
                va5[it] = (u32x4){0u, 0u, 0u, 0u};
                if (idx < 158 * 16 && !(first && j < 30)) va5[it] = *(GAS const u32x4*)(Zall + (size_t)(row0 + j) * 1536 + 128 * cc + 8 * q + 512); }
#pragma unroll
            for (int it = 0; it < 5; ++it) { const int idx = tid + it * NT, j = idx >> 4, q = idx & 15;
                if (idx < 158 * 16) { const u32x4 va = va5[it];
                    *(LAS f32x4*)(vt + j * 128 + 8 * q) = (f32x4){bflo(va.x), bfhi(va.x), bflo(va.y), bfhi(va.y)}; *(LAS f32x4*)(vt + j * 128 + 8 * q + 4) = (f32x4){bflo(va.z), bfhi(va.z), bflo(va.w), bfhi(va.w)}; } }
        }
        __syncthreads();
        const int c = tid & 127, tq = tid >> 7, ch = 128 * cc + c;
        float w[31];
#pragma unroll
        for (int k = 0; k < 31; ++k) w[k] = p.in[14][k * 512 + ch];
        const float bias = p.in[15][ch];
        for (int blk = 0; blk < 4; ++blk) {
            const int tb = 32 * tq + 8 * blk;
            float acc[8];
#pragma unroll
            for (int o = 0; o < 8; ++o) acc[o] = bias;
#pragma unroll
            for (int jj = 0; jj < 38; ++jj) {
                const float vv = vt[(tb + jj) * 128 + c];
#pragma unroll
                for (int o = 0; o < 8; ++o) { const int k = jj - o; if (k >= 0 && k <= 30) acc[o] += w[k] * vv; }
            }
#pragma unroll
            for (int o = 0; o < 8; ++o) YC[(size_t)(tb + o) * 512 + ch] = acc[o];
        }
    }
    __syncthreads();
    int tile2 = tile; asm volatile("" : "+s"(tile2));
    gcfp  YC2 = (gcfp)(p.ws + WS_PRIV + (size_t)tile2 * PRIV_BYTES);
    f32x4 lg0 = *(GAS const f32x4*)(p.in[16] + 8 * lane), lg1 = *(GAS const f32x4*)(p.in[16] + 8 * lane + 4), lb0 = *(GAS const f32x4*)(p.in[17] + 8 * lane), lb1 = *(GAS const f32x4*)(p.in[17] + 8 * lane + 4);
#pragma unroll 1
    for (int r0 = wid; r0 < TILE; r0 += 4 * NW) {
        f32x4 ya[4], yb[4]; float s[4], q[4];
#pragma unroll
        for (int i = 0; i < 4; ++i) { ya[i] = *(GAS const f32x4*)(YC2 + (size_t)(r0 + 8 * i) * 512 + 8 * lane); yb[i] = *(GAS const f32x4*)(YC2 + (size_t)(r0 + 8 * i) * 512 + 8 * lane + 4); }
#pragma unroll
        for (int i = 0; i < 4; ++i) s[i] = (ya[i].x + ya[i].y) + (ya[i].z + ya[i].w) + (yb[i].x + yb[i].y) + (yb[i].z + yb[i].w);
#pragma unroll
        for (int i = 0; i < 4; ++i) s[i] = wave_sum_dpp(s[i]) * (1.0f / 512.0f);
#pragma unroll
        for (int i = 0; i < 4; ++i) { ya[i] = ya[i] - s[i]; yb[i] = yb[i] - s[i];
            q[i] = (ya[i].x * ya[i].x + ya[i].y * ya[i].y) + (ya[i].z * ya[i].z + ya[i].w * ya[i].w) + (yb[i].x * yb[i].x + yb[i].y * yb[i].y) + (yb[i].z * yb[i].z + yb[i].w * yb[i].w); }
#pragma unroll
        for (int i = 0; i < 4; ++i) q[i] = wave_sum_dpp(q[i]);
#pragma unroll
        for (int i = 0; i < 4; ++i) {
            const float rstd = 1.0f / sqrtf(q[i] * (1.0f / 512.0f) + EPS);
            const f32x4 n0 = ya[i] * rstd * lg0 + lb0, n1 = yb[i] * rstd * lg1 + lb1;
            float o[8] = {n0.x, n0.y, n0.z, n0.w, n1.x, n1.y, n1.z, n1.w};
#pragma unroll
            for (int e = 0; e < 8; ++e) o[e] = o[e] * __builtin_amdgcn_rcpf(1.0f + __expf(-o[e]));
            u32x4 wv; wv.x = cvt_pk_bf16(o[0], o[1]); wv.y = cvt_pk_bf16(o[2], o[3]); wv.z = cvt_pk_bf16(o[4], o[5]); wv.w = cvt_pk_bf16(o[6], o[7]);
            *(GAS u32x4*)(ACT + (size_t)(r0 + 8 * i) * 1024 + 512 + 8 * lane) = wv;
        }
    }
}

__device__ __forceinline__ void tile_publish(GAS unsigned* flags, int tile, int wid);
__device__ void phaseA(const KP& p, LAS unsigned char* lds, int tile, int, int wid, int) {
    int lane = lane_id(); int tid = wid * 64 + lane; (void)tid;
    OPAQUE_S(tile); OPAQUE_V(lane);
    gucp XQ = p.ws + WS_XQ + (size_t)tile * TILE * 1024; gfp SX = (gfp)(p.ws + WS_SX) + (size_t)tile * TILE;
    rmsnorm_tile_q8(p.in[0] + (size_t)tile * TILE * D, p.in[1], XQ, SX, wid, lane);
    __syncthreads();
    gbp  Z = (gbp)(p.ws + WS_Z) + (size_t)tile * TILE * 1536;
#pragma unroll 1
    for (int nt = 0; nt < 6; ++nt) {
        if (nt == 2) {
            __syncthreads();
            s5_tile<false>(p, lds, tile, wid, lane);
            OPAQUE_S(tile); OPAQUE_V(lane);
        }
        i32x16 acc[2][2]; EpiSc es;
        load_episc(es, (gcfp)SX, (gcfp)(p.ws + WS_WSC) + WSC_WIN + nt * 256, wid, lane);
        gemm_tile_i8(lds, XQ, 1024, p.ws + WS_WIN8 + (size_t)nt * 256 * 1024, 1024, 1024, acc, wid, lane);
        if (nt < 2) {
            gbp  zl = launder(Z + (size_t)GEMM_RB(wid, lane) * 1536 + nt * 256 + GEMM_CB(wid, lane));
            GEMM_FOR_FRAGS_I(acc, { gbp zg = launder(zl + fo_r * 1536 + fo_c);
                _Pragma("unroll") for (int i4 = 0; i4 < 16; i4 += 4) { _Pragma("unroll") for (int i = i4; i < i4 + 4; ++i) zg[FR_ROW(i) * 1536] = (bf16)f2bf_hw((float)fr[i] * EPI_SCALE(es, i)); asm volatile("" ::: "memory"); } });
        } else {
            gbp  zl = launder(Z + (size_t)GEMM_RB(wid, lane) * 1536 + 512 + (nt - 2) * 128 + (wid & 3) * 32 + (lane & 31));
#pragma unroll
            for (int m = 0; m < 2; ++m) { gbp zg = launder(zl + m * 32 * 1536);
                _Pragma("unroll") for (int i4 = 0; i4 < 16; i4 += 4) { _Pragma("unroll") for (int i = i4; i < i4 + 4; ++i) {
                    const float rsc = es.rs[m][i >> 2][i & 3];
                    const float vv_ = (float)acc[m][0][i] * (es.cs[0] * rsc), gg_ = (float)acc[m][1][i] * (es.cs[1] * rsc);
                    zg[FR_ROW(i) * 1536] = (bf16)f2bf_hw(vv_ * __builtin_amdgcn_rcpf(1.0f + __expf(-gg_))); } asm volatile("" ::: "memory"); } }
        }
    }
}

__device__ void mixer_tile(const KP& p, LAS unsigned char* lds, int tile, int, int wid, int) {
    int lane = lane_id(); int tid = wid * 64 + lane; (void)tid;
    OPAQUE_S(tile); OPAQUE_V(lane);
    gbp  ACT = (gbp)(p.ws + WS_ACT) + (size_t)tile * TILE * 1024;
    gcbp  YS = (gcbp)(p.ws + WS_PRIV + (size_t)tile * PRIV_BYTES + 262144);
    s5_tile<true>(p, lds, tile, wid, lane);
    __syncthreads();
    conv_tile(p, lds, tile, tid, wid, lane);
    __syncthreads();
    gucp XQ = p.ws + WS_XQ + (size_t)tile * TILE * 1024; gfp SX = (gfp)(p.ws + WS_SX) + (size_t)tile * TILE;
    quant_tile_bf16<512>(YS, 512, XQ, SX, wid, lane);
    __syncthreads();
#pragma unroll 1
    for (int nt = 0; nt < 2; ++nt) {
        i32x16 acc[2][2]; EpiSc es;
        load_episc(es, (gcfp)SX, (gcfp)(p.ws + WS_WSC) + WSC_WGLU + nt * 256, wid, lane);
        gemm_tile_i8(lds, XQ, 1024, p.ws + WS_WGLU + (size_t)nt * 256 * 512, 512, 512, acc, wid, lane);
        gcbp  yl = launder(YS + (size_t)GEMM_RB(wid, lane) * 512 + nt * 256 + GEMM_CB(wid, lane));
        gbp  al = launder(ACT + (size_t)GEMM_RB(wid, lane) * 1024 + nt * 256 + GEMM_CB(wid, lane));
        bf16 t[2][2][16];
#pragma unroll
        for (int m = 0; m < 2; ++m)
#pragma unroll
            for (int n = 0; n < 2; ++n) { gcbp yg = launder(yl + m * 32 * 512 + n * 32);
#pragma unroll
                for (int i = 0; i < 16; ++i) t[m][n][i] = yg[FR_ROW(i) * 512]; }
        GEMM_FOR_FRAGS_I(acc, { gbp ag = launder(al + fo_r * 1024 + fo_c);
            _Pragma("unroll") for (int i = 0; i < 16; ++i) ag[FR_ROW(i) * 1024] = (bf16)f2bf_hw(bf2f(t[_m][_n][i]) * __builtin_amdgcn_rcpf(1.0f + __expf(-(float)fr[i] * EPI_SCALE(es, i)))); });
    }
    __syncthreads();
    OPAQUE_S(tile); OPAQUE_V(lane);
    gcfp  xin = p.in[0] + (size_t)tile * TILE * D; gbp  XB = XB_TILE(p, tile);
    quant_tile_bf16<1024>(ACT, 1024, XQ, SX, wid, lane);
    __syncthreads();
#pragma unroll 1
    for (int nt = 0; nt < 4; ++nt) {
        i32x16 acc[2][2]; EpiSc es;
        load_episc(es, (gcfp)SX, (gcfp)(p.ws + WS_WSC) + WSC_WOUT + nt * 256, wid, lane);
        gemm_tile_i8(lds, XQ, 1024, p.ws + WS_WOUT + (size_t)nt * 256 * 1024, 1024, 1024, acc, wid, lane);
        gcfp  xl = launder(xin + (size_t)GEMM_RB(wid, lane) * D + nt * 256 + GEMM_CB(wid, lane));
        gbp  ol = launder(XB + (size_t)GEMM_RB(wid, lane) * D + nt * 256 + GEMM_CB(wid, lane));
        float t[2][2][16];
#pragma unroll
        for (int m = 0; m < 2; ++m)
#pragma unroll
            for (int n = 0; n < 2; ++n) { gcfp xg = launder(xl + m * 32 * D + n * 32);
#pragma unroll
                for (int i = 0; i < 16; ++i) t[m][n][i] = xg[FR_ROW(i) * D]; }
        GEMM_FOR_FRAGS_I(acc, { gbp og = launder(ol + fo_r * D + fo_c);
            _Pragma("unroll") for (int i = 0; i < 16; ++i) og[FR_ROW(i) * D] = (bf16)f2bf_hw(t[_m][_n][i] + (float)fr[i] * EPI_SCALE(es, i)); });
    }
    __syncthreads();
}

typedef __bf16 bf16x2_t __attribute__((ext_vector_type(2)));
__device__ __forceinline__ float dot2bf(unsigned a, unsigned b, float c) { return __builtin_amdgcn_fdot2_f32_bf16(__builtin_bit_cast(bf16x2_t, a), __builtin_bit_cast(bf16x2_t, b), c, false); }
__device__ __forceinline__ int f2sort(float f) { const int b = __builtin_bit_cast(int, f); return b ^ ((b >> 31) & 0x7fffffff); }
__device__ __forceinline__ float sort2f(int s) { const int b = s ^ ((s >> 31) & 0x7fffffff); return __builtin_bit_cast(float, b); }
__device__ __forceinline__ void sort16_desc(int (&v)[16]) {
#pragma unroll
    for (int k = 2; k <= 16; k <<= 1)
#pragma unroll
        for (int j = k >> 1; j > 0; j >>= 1)
#pragma unroll
            for (int i = 0; i < 16; ++i) { const int l = i ^ j; if (l > i) { const bool desc = ((i & k) == 0); const int a = v[i], b = v[l], mx = max(a, b), mn = min(a, b); v[i] = desc ? mx : mn; v[l] = desc ? mn : mx; } }
}
__device__ __forceinline__ void bitonic_merge16_desc(int (&v)[16]) {
#pragma unroll
    for (int j = 8; j > 0; j >>= 1)
#pragma unroll
        for (int i = 0; i < 16; ++i) { const int l = i ^ j; if (l > i) { const int a = v[i], b = v[l]; v[i] = max(a, b); v[l] = min(a, b); } }
}
__device__ __forceinline__ void merge_top16(int (&a)[16], const int (&b)[16]) {
#pragma unroll
    for (int i = 0; i < 16; ++i) a[i] = max(a[i], b[15 - i]);
    bitonic_merge16_desc(a);
}

constexpr size_t PRIV_LISTS = 0;

__device__ __forceinline__ void grid_barrier(gucp ws, unsigned idx, int wid);
__device__ void peer_tile(const KP& p, LAS unsigned char* lds, int layer, int tile, int, int wid, int) {
    int lane = lane_id(); int tid = wid * 64 + lane; (void)tid;
    OPAQUE_S(tile); OPAQUE_V(lane); OPAQUE_V(tid);
    gbp ACT = (gbp)(p.ws + WS_ACT) + (size_t)tile * TILE * 1024;
    gbp XB = XB_TILE(p, tile);
    GAS int* LISTS = (GAS int*)(layer == 0 ? p.ws + WS_PRIV + (size_t)tile * PRIV_BYTES + PRIV_LISTS : p.ws + WS_ACT + (size_t)tile * TILE * 2048);
    gcucp WQ = p.ws + WS_WQ8 + (size_t)layer * 2048 * 1024;
    const int lr = lane & 31, lh = lane >> 5;
    rmsnorm_tile_q8_bf(XB, p.in[2] + layer * D, p.ws + WS_XQ + (size_t)tile * TILE * 1024, (gfp)(p.ws + WS_SX) + (size_t)tile * TILE, wid, lane, 1.0f / 119.0f);
    __syncthreads();
#pragma unroll 1
    for (int h = 0; h < 8; ++h) {
        {
            const int c = wid >> 2, tg = wid & 3;
            const float sxs = ((gcfp)(p.ws + WS_SX))[(size_t)tile * TILE + tg * 32 + lr];
            gcfp swl = (gcfp)(p.ws + WS_WSC) + WSC_WQ + layer * 2048 + h * 256 + c * 128;
            float smf[4];
#pragma unroll
            for (int mf = 0; mf < 4; ++mf) smf[mf] = swl[mf * 32] * sxs;
            i32x16 sc[4];
            gemm_scores_i8(lds, p.ws + WS_XQ + (size_t)tile * TILE * 1024, 1024, WQ + (size_t)h * 256 * 1024, 1024, 1024, sc, wid, lane);
            int best[16];
#pragma unroll
            for (int mf = 0; mf < 4; ++mf) {
                int v[16];
#pragma unroll
                for (int i = 0; i < 16; ++i) v[i] = (f2sort((float)sc[mf][i] * smf[mf]) & ~0x7F) | (mf * 32 + FR_ROW(i) + 4 * lh);
                sort16_desc(v);
                if (mf == 0) {
#pragma unroll
                    for (int i = 0; i < 16; ++i) best[i] = v[i];
                } else merge_top16(best, v);
            }
            int oth[16];
#pragma unroll
            for (int i = 0; i < 16; ++i) oth[i] = __shfl_xor(best[i], 32);
            merge_top16(best, oth);
            GAS int* dst = LISTS + ((size_t)(h * 2 + c) * 128 + tg * 32 + lr) * 16 + lh * 8;
            typedef int i32x4 __attribute__((ext_vector_type(4)));
            i32x4 o0, o1;
            if (lh == 0) { o0 = (i32x4){best[0], best[1], best[2], best[3]}; o1 = (i32x4){best[4], best[5], best[6], best[7]}; }
            else { o0 = (i32x4){best[8], best[9], best[10], best[11]}; o1 = (i32x4){best[12], best[13], best[14], best[15]}; }
            *(GAS i32x4*)dst = o0; *(GAS i32x4*)(dst + 4) = o1;
        }
    }
    __syncthreads();
    {
        OPAQUE_S(tile); OPAQUE_V(tid);
        GAS int* IDS = (GAS int*)(p.ws + WS_IDS) + (size_t)tile * TILE * 128;
        gfp GA = (gfp)(p.ws + WS_GATES) + (size_t)tile * TILE * 128; gfp GB = (gfp)(p.ws + WS_GB) + (size_t)tile * TILE * 128;
        gcfp SU = (gcfp)(p.ws + WS_SU) + layer * 16384; gcfp SV = (gcfp)(p.ws + WS_SV) + layer * 16384; gcfp SX = (gcfp)(p.ws + WS_SX) + (size_t)tile * TILE;
        typedef int i32x4 __attribute__((ext_vector_type(4)));
#pragma unroll 1
        for (int rep = 0; rep < 2; ++rep) {
            const int idx = tid + rep * NT, t = idx & 127, h = idx >> 7;
            GAS const int* la = LISTS + ((size_t)(h * 2 + 0) * 128 + t) * 16;
            GAS const int* lb = LISTS + ((size_t)(h * 2 + 1) * 128 + t) * 16;
            float va[16], vb[16]; int ka[16], kb[16];
#pragma unroll
            for (int q = 0; q < 4; ++q) { const i32x4 a4 = *(GAS const i32x4*)(la + 4 * q), b4 = *(GAS const i32x4*)(lb + 4 * q);
#pragma unroll
                for (int e = 0; e < 4; ++e) { va[4 * q + e] = sort2f(a4[e] & ~0x7F); vb[4 * q + e] = sort2f(b4[e] & ~0x7F); ka[4 * q + e] = (a4[e] & 0x7F) << 7; kb[4 * q + e] = b4[e] & 0x7F; } }
            int best[16];
            constexpr int IMIN = (int)0x80000000;
#pragma unroll
            for (int grp = 0; grp < 4; ++grp) {
                int v[16];
#pragma unroll
                for (int e = 0; e < 16; ++e) v[e] = IMIN;
                {
                    int n = 0;
#pragma unroll
                    for (int i = 0; i < 16; ++i)
#pragma unroll
                        for (int j = 0; j < 16; ++j) if ((i + 1) * (j + 1) <= 16) { if (n >= 16 * grp && n < 16 * grp + 16) v[n - 16 * grp] = ((f2sort(va[i] + vb[j]) + 0x2000) & ~0x3FFF) | ka[i] | kb[j]; ++n; }
                }
                sort16_desc(v);
                if (grp == 0) {
#pragma unroll
                    for (int e = 0; e < 16; ++e) best[e] = v[e];
                } else merge_top16(best, v);
            }
            float ev[16]; float sum = 0.f; const float mx = sort2f(best[0] & ~0x3FFF);
#pragma unroll
            for (int e = 0; e < 16; ++e) { ev[e] = __expf(sort2f(best[e] & ~0x3FFF) - mx); sum += ev[e]; }
            const float inv = 1.0f / sum;
            int ids[16];
#pragma unroll
            for (int e = 0; e < 16; ++e) ids[e] = best[e] & 0x3FFF;
            GAS int* io = IDS + ((size_t)h * 128 + t) * 16; gfp ga = GA + ((size_t)h * 128 + t) * 16; gfp gb = GB + ((size_t)h * 128 + t) * 16;
#pragma unroll
            for (int q = 0; q < 4; ++q) { *(GAS i32x4*)(io + 4 * q) = (i32x4){ids[4 * q], ids[4 * q + 1], ids[4 * q + 2], ids[4 * q + 3]};
                *(GAS f32x4*)(ga + 4 * q) = (f32x4){ev[4 * q] * inv, ev[4 * q + 1] * inv, ev[4 * q + 2] * inv, ev[4 * q + 3] * inv}; }
            (void)gb;
        }
    }
    __syncthreads();
    {
        OPAQUE_S(tile); OPAQUE_V(lane);
        gcucp PU = (gcucp)(p.ws + WS_PU) + (size_t)layer * 16384 * 512;
        gcucp PV = (gcucp)(p.ws + WS_PV) + (size_t)layer * 16384 * 1024;
        GAS const int* IDS = (GAS const int*)(p.ws + WS_IDS) + (size_t)tile * TILE * 128;
        gcfp GA = (gcfp)(p.ws + WS_GATES) + (size_t)tile * TILE * 128;
        gcfp SUl = (gcfp)(p.ws + WS_SU) + layer * 16384; gcfp SVl = (gcfp)(p.ws + WS_SV) + layer * 16384; gcfp SXt = (gcfp)(p.ws + WS_SX) + (size_t)tile * TILE;
        typedef int i32x4 __attribute__((ext_vector_type(4)));
        constexpr int SW_TOK = 4, SW_N = 16 / SW_TOK, SW_PAIRS = SW_TOK * 128, PB = 8;
        const __amdgpu_buffer_rsrc_t rsu = __builtin_amdgcn_make_buffer_rsrc((void*)PU, (short)0, 16384 * 512, 0x00020000);
        const __amdgpu_buffer_rsrc_t rsv = __builtin_amdgcn_make_buffer_rsrc((void*)PV, (short)0, 16384 * 1024, 0x00020000);
        LAS unsigned char* wl = lds + wid * 13312;
        LAS unsigned* list = (LAS unsigned*)wl; LAS unsigned char* xl = wl + 4096; LAS unsigned* hist = (LAS unsigned*)(wl + 12288);
#pragma unroll 1
        for (int sweep = 0; sweep < SW_N; ++sweep) {
            const int tok0 = wid * 16 + sweep * SW_TOK;
            __syncthreads();
            hist[lane] = 0u; hist[lane + 64] = 0u;
            const unsigned rev = (sweep & 1) ? 127u : 0u;
            unsigned key[2 * SW_TOK];
#pragma unroll
            for (int s = 0; s < SW_TOK; ++s) {
                {
                    const i32x4 xr4 = *(GAS const i32x4*)(p.ws + WS_XQ + ((size_t)tile * TILE + tok0 + s) * 1024 + 16 * lane);
                    unsigned lo16[4], hi16[4];
#pragma unroll
                    for (int c4 = 0; c4 < 4; ++c4) { const unsigned xw = (unsigned)xr4[c4];
                        unsigned lo = xw & 0x0f0f0f0fu, hi = (((xw >> 4) & 0x0f0f0f0fu) + ((xw >> 3) & 0x01010101u)) & 0x0f0f0f0fu;
                        lo = (lo | (lo >> 4)) & 0x00ff00ffu; lo = (lo | (lo >> 8)) & 0xffffu; hi = (hi | (hi >> 4)) & 0x00ff00ffu; hi = (hi | (hi >> 8)) & 0xffffu;
                        lo16[c4] = lo; hi16[c4] = hi; }
                    i32x4 xs; xs.x = (int)(lo16[0] | (lo16[1] << 16)); xs.y = (int)(hi16[0] | (hi16[1] << 16)); xs.z = (int)(lo16[2] | (lo16[3] << 16)); xs.w = (int)(hi16[2] | (hi16[3] << 16));
                    *(LAS i32x4*)(xl + s * 1024 + 16 * lane) = xs;
                }
                key[2 * s] = (unsigned)IDS[((size_t)(lane >> 4) * 128 + tok0 + s) * 16 + (lane & 15)] | (unsigned)(s << 14) | ((unsigned)lane << 17);
                key[2 * s + 1] = (unsigned)IDS[((size_t)(4 + (lane >> 4)) * 128 + tok0 + s) * 16 + (lane & 15)] | (unsigned)(s << 14) | ((unsigned)(lane + 64) << 17);
            }
#pragma unroll
            for (int i = 0; i < 2 * SW_TOK; ++i) __hip_atomic_fetch_add(hist + (((key[i] & 0x3fffu) >> 7) ^ rev), 1u, __ATOMIC_RELAXED, __HIP_MEMORY_SCOPE_WORKGROUP);
            {
                const unsigned h0 = hist[2 * lane], h1 = hist[2 * lane + 1];
                unsigned incl = h0 + h1;
#pragma unroll
                for (int o = 1; o < 64; o <<= 1) { const unsigned t = __shfl_up(incl, o); if (lane >= o) incl += t; }
                const unsigned excl = incl - (h0 + h1);
                hist[2 * lane] = excl; hist[2 * lane + 1] = excl + h0;
            }
#pragma unroll
            for (int i = 0; i < 2 * SW_TOK; ++i) { const unsigned pos = __hip_atomic_fetch_add(hist + (((key[i] & 0x3fffu) >> 7) ^ rev), 1u, __ATOMIC_RELAXED, __HIP_MEMORY_SCOPE_WORKGROUP); list[pos] = key[i]; }
            typedef _Float16 f16x4 __attribute__((ext_vector_type(4)));
            f32x4 accq[16]; float wsumv = 0.f;
#pragma unroll
            for (int q = 0; q < 16; ++q) accq[q] = (f32x4){0.f, 0.f, 0.f, 0.f};
#pragma unroll 1
            for (int chunk = 0; chunk < SW_PAIRS / 64; ++chunk) {
                if (chunk == 2 || chunk == 5) __syncthreads();
                const unsigned k64 = list[chunk * 64 + lane];
                const int sl = (k64 >> 14) & 7, jl = k64 >> 17;
                const int id64 = (int)(k64 & 0x3fffu);
                const float fa64 = SUl[id64] * SXt[tok0 + sl], fb64 = GA[((size_t)(jl >> 4) * 128 + tok0 + sl) * 16 + (jl & 15)] * SVl[id64];
#pragma unroll 1
                for (int i = 0; i < 64; i += PB) {
                    u32x2 uu[PB]; u32x4 vv[PB]; int sk[PB];
#pragma unroll
                    for (int k = 0; k < PB; ++k) {
                        const unsigned kk = (unsigned)__builtin_amdgcn_readlane((int)k64, i + k);
                        const int eo = (int)((kk & 0x3fffu) << 10); sk[k] = (kk >> 14) & 7;
                        uu[k] = __builtin_bit_cast(u32x2, __builtin_amdgcn_raw_buffer_load_b64(rsu, 8 * lane, (int)((kk & 0x3fffu) << 9), 0));
                        vv[k] = __builtin_bit_cast(u32x4, __builtin_amdgcn_raw_buffer_load_b128(rsv, 16 * lane, eo, 0));
                    }
                    float dd[PB];
#pragma unroll
                    for (int k = 0; k < PB; ++k) {
                        const i32x4 xx = *(const LAS i32x4*)(xl + sk[k] * 1024 + 16 * lane);
                        const int dhi = __builtin_amdgcn_sdot8(xx.y, (int)uu[k].x, __builtin_amdgcn_sdot8(xx.w, (int)uu[k].y, 0, false), false);
                        dd[k] = (float)__builtin_amdgcn_sdot8(xx.x, (int)uu[k].x, __builtin_amdgcn_sdot8(xx.z, (int)uu[k].y, dhi << 4, false), false);
                    }
                    float tot;
                    {
                        const bool b0 = lane & 1, b1 = lane & 2, b2 = lane & 4;
                        float r1[4], r2[2];
#pragma unroll
                        for (int m = 0; m < 4; ++m) { const float keep = b0 ? dd[2 * m + 1] : dd[2 * m], send = b0 ? dd[2 * m] : dd[2 * m + 1]; r1[m] = keep + dppf<0xB1>(send); }
#pragma unroll
                        for (int m = 0; m < 2; ++m) { const float keep = b1 ? r1[2 * m + 1] : r1[2 * m], send = b1 ? r1[2 * m] : r1[2 * m + 1]; r2[m] = keep + dppf<0x4E>(send); }
                        const float keep = b2 ? r2[1] : r2[0], send = b2 ? r2[0] : r2[1];
                        tot = keep + __builtin_bit_cast(float, __builtin_amdgcn_ds_swizzle(__builtin_bit_cast(int, send), 0x101f));
                        tot += dppf<0x128>(tot);
                        auto s16 = __builtin_amdgcn_permlane16_swap(__float_as_uint(tot), __float_as_uint(tot), false, false);
                        tot = __uint_as_float(s16[0]) + __uint_as_float(s16[1]);
                        auto s32 = __builtin_amdgcn_permlane32_swap(__float_as_uint(tot), __float_as_uint(tot), false, false);
                        tot = __uint_as_float(s32[0]) + __uint_as_float(s32[1]);
                    }
                    const float fav = __shfl(fa64, i + (lane & 7)), fbv = __shfl(fb64, i + (lane & 7));
                    const float wv = (float)(_Float16)(gelu_fast(tot * fav) * fbv * 4096.0f);
#pragma unroll
                    for (int g = 0; g < PB / 4; ++g) {
                        float sel[4];
#pragma unroll
                        for (int k = 0; k < 4; ++k) { const float w = __builtin_bit_cast(float, __builtin_amdgcn_readlane(__builtin_bit_cast(int, wv), 4 * g + k));
                            sel[k] = (sk[4 * g + k] == (lane & 3)) ? w : 0.f; wsumv += sel[k]; }
                        const f16x4 am = {(_Float16)sel[0], (_Float16)sel[1], (_Float16)sel[2], (_Float16)sel[3]};
                        u32x2 bwq[16];
#pragma unroll
                        for (int q = 0; q < 16; ++q) {
                            constexpr unsigned SELB = 0x0c000c00u; const unsigned selq = SELB | ((4u + (q & 3)) << 16) | (unsigned)(q & 3);
                            bwq[q].x = __builtin_amdgcn_perm(vv[4 * g + 1][q >> 2], vv[4 * g + 0][q >> 2], selq); bwq[q].y = __builtin_amdgcn_perm(vv[4 * g + 3][q >> 2], vv[4 * g + 2][q >> 2], selq);
                            if (q >= 1) { accq[q - 1] = __builtin_amdgcn_mfma_f32_4x4x4f16(am, __builtin_bit_cast(f16x4, bwq[q - 1]), accq[q - 1], 0, 0, 0); __builtin_amdgcn_sched_barrier(0); }
                        }
                        accq[15] = __builtin_amdgcn_mfma_f32_4x4x4f16(am, __builtin_bit_cast(f16x4, bwq[15]), accq[15], 0, 0, 0);
                    }
                }
            }
#pragma unroll
            for (int s = 0; s < SW_TOK; ++s) {
                gbp xr = XB + (size_t)(tok0 + s) * D + 16 * lane;
                const float corr = __builtin_bit_cast(float, __builtin_amdgcn_readlane(__builtin_bit_cast(int, wsumv), s)) * (128.0f / 4096.0f);
                const u32x4 r0 = *(GAS const u32x4*)xr, r1 = *(GAS const u32x4*)(xr + 8);
                float xv[16];
#pragma unroll
                for (int q = 0; q < 8; ++q) { const unsigned w = q < 4 ? r0[q & 3] : r1[q & 3]; xv[2 * q] = __uint_as_float(w << 16); xv[2 * q + 1] = __uint_as_float(w & 0xffff0000u); }
#pragma unroll
                for (int q = 0; q < 16; ++q) xv[q] += accq[q][s] * 4096.0f - corr;
                if (layer == 0) {
                    u32x4 o0, o1;
#pragma unroll
                    for (int q = 0; q < 4; ++q) { o0[q] = cvt_pk_bf16(xv[2 * q], xv[2 * q + 1]); o1[q] = cvt_pk_bf16(xv[8 + 2 * q], xv[8 + 2 * q + 1]); }
                    *(GAS u32x4*)xr = o0; *(GAS u32x4*)(xr + 8) = o1;
                } else {
                    float ss = 0.f;
#pragma unroll
                    for (int q = 0; q < 16; ++q) ss += xv[q] * xv[q];
                    ss = wave_sum_dpp(ss);
                    const float rstd = 1.0f / sqrtf(ss * (1.0f / D) + EPS);
                    gfp orow = p.out + ((size_t)tile * TILE + tok0 + s) * D + 16 * lane; gcfp gf = p.in[3] + 16 * lane;
#pragma unroll
                    for (int q = 0; q < 4; ++q) { const f32x4 g4 = *(GAS const f32x4*)(gf + 4 * q);
                        *(GAS f32x4*)(orow + 4 * q) = (f32x4){xv[4 * q] * rstd * g4.x, xv[4 * q + 1] * rstd * g4.y, xv[4 * q + 2] * rstd * g4.z, xv[4 * q + 3] * rstd * g4.w}; }
                }
            }
        }
    }
    __syncthreads();
}

__device__ void qkv_tile(const KP& p, LAS unsigned char* lds, int tile, int, int wid, int) {
    int lane = lane_id(); int tid = wid * 64 + lane; (void)tid;
    OPAQUE_S(tile); OPAQUE_V(lane); OPAQUE_V(tid);
    gcbp XB = XB_TILE(p, tile);
    gbp QKV = (gbp)(p.ws + WS_PRIV + (size_t)tile * PRIV_BYTES);
    gucp XQ = p.ws + WS_XQ + (size_t)tile * TILE * 1024; gfp SX = (gfp)(p.ws + WS_SX) + (size_t)tile * TILE;
    rmsnorm_tile_q8_bf(XB, p.in[1] + D, XQ, SX, wid, lane, 1.0f / 127.0f);
    __syncthreads();
    typedef float f32x2r __attribute__((ext_vector_type(2)));
    const int wc = wid & 3, lr = lane & 31;
    f32x2r cs[2][16];
    {
        GAS const f32x2r* CS = (GAS const f32x2r*)(p.ws + WS_ROPE) + ((size_t)((tile % TILES_PER_SEQ) * TILE + GEMM_RB(wid, lane)) * 8 + (lr & 7));
#pragma unroll
        for (int m = 0; m < 2; ++m)
#pragma unroll
            for (int i = 0; i < 16; ++i) cs[m][i] = CS[(size_t)(32 * m + FR_ROW(i)) * 8];
    }
    const float sgn = (lr & 8) ? 1.0f : -1.0f;
#pragma unroll 1
    for (int nt = 0; nt < 5; ++nt) {
        i32x16 acc[2][2]; EpiSc es;
        load_episc(es, (gcfp)SX, (gcfp)(p.ws + WS_WSC) + WSC_WQKV + nt * 256, wid, lane);
        float bias[2];
#pragma unroll
        for (int n = 0; n < 2; ++n) bias[n] = p.in[20][nt * 256 + GEMM_CB(wid, lane) + 32 * n];
        gemm_tile_i8(lds, XQ, 1024, p.ws + WS_WQKV8 + (size_t)nt * 256 * 1024, 1024, 1024, acc, wid, lane);
        gbp ql = launder(QKV + (size_t)GEMM_RB(wid, lane) * 1280 + nt * 256 + GEMM_CB(wid, lane));
        const bool rot = nt < 4 || wc < 2;
        GEMM_FOR_FRAGS_I(acc, { gbp qg = launder(ql + fo_r * 1280 + fo_c);
            _Pragma("unroll") for (int i4 = 0; i4 < 16; i4 += 4) { _Pragma("unroll") for (int i = i4; i < i4 + 4; ++i) {
                float v = (float)fr[i] * EPI_SCALE(es, i) + bias[_n];
                if (_n == 0) { const float pv = dppf<0x128>(v);
                    const float r = v * cs[_m][i].x + pv * (sgn * cs[_m][i].y); v = (rot && lr < 16) ? r : v; }
                qg[FR_ROW(i) * 1280] = (bf16)f2bf_hw(v); } asm volatile("" ::: "memory"); } });
    }
    __syncthreads();
}

constexpr int AT_K = 0, AT_VT = 65536, AT_VROW = 520;
__device__ void attn_tile(const KP& p, LAS unsigned char* lds, int tile, int, int wid, int) {
    int lane = lane_id(); int tid = wid * 64 + lane; (void)tid;
    OPAQUE_S(tile); OPAQUE_V(lane); OPAQUE_V(tid);
    const bool has_prev = (tile % TILES_PER_SEQ) != 0;
    gcbp QKVc = (gcbp)(p.ws + WS_PRIV + (size_t)tile * PRIV_BYTES);
    gcbp QKVp = (gcbp)(p.ws + WS_PRIV + (size_t)(tile - 1) * PRIV_BYTES);
    gbp ATT = (gbp)(p.ws + WS_ACT) + (size_t)tile * TILE * 1024;
    __syncthreads();
    {
        u32x4 kk8[8], vv8[8];
#pragma unroll
        for (int it = 0; it < 8; ++it) {
            const int idx = tid + it * NT, c = idx & 7, kw = (idx >> 3) & 255, kv = idx >> 11;
            kk8[it] = (u32x4){0u, 0u, 0u, 0u}; vv8[it] = (u32x4){0u, 0u, 0u, 0u};
            if (kw >= 128 || has_prev) {
                gcbp row = (kw >= 128 ? QKVc + (size_t)(kw - 128) * 1280 : QKVp + (size_t)kw * 1280);
                kk8[it] = *(GAS const u32x4*)(row + 1024 + kv * 64 + c * 8);
                vv8[it] = *(GAS const u32x4*)(row + 1152 + kv * 64 + c * 8);
            }
        }
#pragma unroll
        for (int it = 0; it < 8; ++it) {
            const int idx = tid + it * NT, c = idx & 7, kw = (idx >> 3) & 255, kv = idx >> 11;
            const u32x4 kk = kk8[it], vv = vv8[it];
            *(LAS u32x4*)(lds + AT_K + (kv * 256 + kw) * 128 + ((c ^ ((kw >> 1) & 7)) * 16)) = kk;
            LAS unsigned char* vt = lds + AT_VT + (kv * 64 + c * 8) * AT_VROW + kw * 2;
            *(LAS bf16*)(vt + 0 * AT_VROW) = (bf16)(vv.x & 0xffff); *(LAS bf16*)(vt + 1 * AT_VROW) = (bf16)(vv.x >> 16);
            *(LAS bf16*)(vt + 2 * AT_VROW) = (bf16)(vv.y & 0xffff); *(LAS bf16*)(vt + 3 * AT_VROW) = (bf16)(vv.y >> 16);
            *(LAS bf16*)(vt + 4 * AT_VROW) = (bf16)(vv.z & 0xffff); *(LAS bf16*)(vt + 5 * AT_VROW) = (bf16)(vv.z >> 16);
            *(LAS bf16*)(vt + 6 * AT_VROW) = (bf16)(vv.w & 0xffff); *(LAS bf16*)(vt + 7 * AT_VROW) = (bf16)(vv.w >> 16);
        }
    }
    __syncthreads();
    const int lr = lane & 31, lh = lane >> 5, kv = wid >> 2;
    LAS unsigned char* Kl = lds + AT_K + kv * 256 * 128;
    LAS unsigned char* Vl = lds + AT_VT + kv * 64 * AT_VROW;
    bf16x8 qnext[4];
#pragma unroll
    for (int ks = 0; ks < 4; ++ks) qnext[ks] = *(GAS const bf16x8*)(QKVc + (size_t)lr * 1280 + (wid * 2) * 64 + ks * 16 + lh * 8);
#pragma unroll 1
    for (int unit = 0; unit < 8; ++unit) {
        const int head = wid * 2 + (unit >> 2), qf = unit & 3;
        bf16x8 qb[4];
#pragma unroll
        for (int ks = 0; ks < 4; ++ks) qb[ks] = qnext[ks];
        { const int un = min(unit + 1, 7), hn = wid * 2 + (un >> 2), qn = un & 3;
#pragma unroll
            for (int ks = 0; ks < 4; ++ks) qnext[ks] = *(GAS const bf16x8*)(QKVc + (size_t)(qn * 32 + lr) * 1280 + hn * 64 + ks * 16 + lh * 8); }
        f32x16 s[5];
#pragma unroll
        for (int f = 0; f < 5; ++f) {
#pragma unroll
            for (int i = 0; i < 16; ++i) s[f][i] = 0.f;
            const int row = (qf + f) * 32 + lr;
#pragma unroll
            for (int ks = 0; ks < 4; ++ks) { const bf16x8 ka = *(const LAS bf16x8*)(Kl + row * 128 + (((2 * ks + lh) ^ ((row >> 1) & 7)) * 16));
                s[f] = __builtin_amdgcn_mfma_f32_32x32x16_bf16(ka, qb[ks], s[f], 0, 0, 0); }
        }
        const int q = qf * 32 + lr;
        const float sink = p.in[21][head];
        float mx = sink;
#pragma unroll
        for (int f = 0; f < 5; ++f) {
            const bool frag_ok = (qf + f >= 4) || has_prev;
#pragma unroll
            for (int i = 0; i < 16; ++i) { const int d = FR_ROW(i) + 4 * lh - lr;
                const bool ok = frag_ok && (f == 0 ? d >= 1 : f == 4 ? d <= 0 : true);
                const float v = ok ? s[f][i] * 0.125f : -INFINITY; s[f][i] = v; mx = fmaxf(mx, v); }
        }
        mx = fmaxf(mx, __shfl_xor(mx, 32));
        float sum = 0.f;
#pragma unroll
        for (int f = 0; f < 5; ++f)
#pragma unroll
            for (int i = 0; i < 16; ++i) { const float e = __expf(s[f][i] - mx); s[f][i] = e; sum += e; }
        sum += __shfl_xor(sum, 32);
        sum += __expf(sink - mx);
        const float inv = 1.0f / sum;
        f32x16 o[2];
#pragma unroll
        for (int m = 0; m < 2; ++m)
#pragma unroll
            for (int i = 0; i < 16; ++i) o[m][i] = 0.f;
#pragma unroll
        for (int f = 0; f < 5; ++f)
#pragma unroll
            for (int st = 0; st < 2; ++st) {
                u32x4 pbu; pbu.x = cvt_pk_bf16(s[f][8 * st + 0], s[f][8 * st + 1]); pbu.y = cvt_pk_bf16(s[f][8 * st + 2], s[f][8 * st + 3]); pbu.z = cvt_pk_bf16(s[f][8 * st + 4], s[f][8 * st + 5]); pbu.w = cvt_pk_bf16(s[f][8 * st + 6], s[f][8 * st + 7]);
                const bf16x8 pb = __builtin_bit_cast(bf16x8, pbu);
                const int kb = (qf + f) * 32 + 16 * st + 4 * lh;
#pragma unroll
                for (int m = 0; m < 2; ++m) {
                    const LAS unsigned char* vr = Vl + (m * 32 + lr) * AT_VROW + kb * 2;
                    const u32x2 lo = *(const LAS u32x2*)vr, hi = *(const LAS u32x2*)(vr + 16);
                    u32x4 vau; vau.x = lo.x; vau.y = lo.y; vau.z = hi.x; vau.w = hi.y;
                    o[m] = __builtin_amdgcn_mfma_f32_32x32x16_bf16(__builtin_bit_cast(bf16x8, vau), pb, o[m], 0, 0, 0);
                }
            }
        gbp orow = ATT + (size_t)q * 1024 + head * 64 + 4 * lh;
#pragma unroll
        for (int m = 0; m < 2; ++m)
#pragma unroll
            for (int g4 = 0; g4 < 4; ++g4) { u32x2 w; w.x = cvt_pk_bf16(o[m][4 * g4] * inv, o[m][4 * g4 + 1] * inv); w.y = cvt_pk_bf16(o[m][4 * g4 + 2] * inv, o[m][4 * g4 + 3] * inv);
                *(GAS u32x2*)(orow + m * 32 + 8 * g4) = w; }
    }
    __syncthreads();
}

__device__ void oproj_tile(const KP& p, LAS unsigned char* lds, int tile, int, int wid, int) {
    int lane = lane_id(); int tid = wid * 64 + lane; (void)tid;
    OPAQUE_S(tile); OPAQUE_V(lane);
    gcbp ATT = (gcbp)(p.ws + WS_ACT) + (size_t)tile * TILE * 1024;
    gbp XB = XB_TILE(p, tile);
    gucp XQ = p.ws + WS_XQ + (size_t)tile * TILE * 1024; gfp SX = (gfp)(p.ws + WS_SX) + (size_t)tile * TILE;
    quant_tile_bf16<1024>(ATT, 1024, XQ, SX, wid, lane);
    __syncthreads();
#pragma unroll 1
    for (int nt = 0; nt < 4; ++nt) {
        i32x16 acc[2][2]; EpiSc es;
        load_episc(es, (gcfp)SX, (gcfp)(p.ws + WS_WSC) + WSC_WO + nt * 256, wid, lane);
        gemm_tile_i8(lds, XQ, 1024, p.ws + WS_WO + (size_t)nt * 256 * 1024, 1024, 1024, acc, wid, lane);
        gbp ol = launder(XB + (size_t)GEMM_RB(wid, lane) * D + nt * 256 + GEMM_CB(wid, lane));
        bf16 t[2][2][16];
#pragma unroll
        for (int m = 0; m < 2; ++m)
#pragma unroll
            for (int n = 0; n < 2; ++n) { gcbp xg = launder((gcbp)ol + m * 32 * D + n * 32);
#pragma unroll
                for (int i = 0; i < 16; ++i) t[m][n][i] = xg[FR_ROW(i) * D]; }
        GEMM_FOR_FRAGS_I(acc, { gbp og = launder(ol + fo_r * D + fo_c);
            _Pragma("unroll") for (int i = 0; i < 16; ++i) og[FR_ROW(i) * D] = (bf16)f2bf_hw(bf2f(t[_m][_n][i]) + (float)fr[i] * EPI_SCALE(es, i)); });
    }
    __syncthreads();
}

template <int R>
__device__ __forceinline__ void rmsnorm_rows_f32(gcfp x0, gcfp g, gfp o0, int lane) {
    f32x4 v[R][4]; float s[R];
#pragma unroll
    for (int i = 0; i < R; ++i)
#pragma unroll
        for (int j = 0; j < 4; ++j) v[i][j] = *(GAS const f32x4*)(x0 + (size_t)i * 8 * D + 4 * lane + 256 * j);
    f32x4 gg[4];
#pragma unroll
    for (int j = 0; j < 4; ++j) gg[j] = *(GAS const f32x4*)(g + 4 * lane + 256 * j);
#pragma unroll
    for (int i = 0; i < R; ++i) { s[i] = 0.f;
#pragma unroll
        for (int j = 0; j < 4; ++j) s[i] += (v[i][j].x * v[i][j].x + v[i][j].y * v[i][j].y) + (v[i][j].z * v[i][j].z + v[i][j].w * v[i][j].w); }
#pragma unroll
    for (int i = 0; i < R; ++i) s[i] = wave_sum_dpp(s[i]);
#pragma unroll
    for (int i = 0; i < R; ++i) { const float rstd = 1.0f / sqrtf(s[i] * (1.0f / D) + EPS);
#pragma unroll
        for (int j = 0; j < 4; ++j) *(GAS f32x4*)(o0 + (size_t)i * 8 * D + 4 * lane + 256 * j) = v[i][j] * rstd * gg[j]; }
}

__device__ __forceinline__ void grid_barrier(gucp ws, unsigned idx, int wid) {
    asm volatile("s_waitcnt vmcnt(0)" ::: "memory");
    __syncthreads();
    if (wid == 0 && lane_id() == 0) {
        __builtin_amdgcn_fence(__ATOMIC_RELEASE, "agent");
        asm volatile("s_waitcnt vmcnt(0)" ::: "memory");
        GAS unsigned* cnt = (GAS unsigned*)(ws + WS_CTL) + 64;
        __hip_atomic_fetch_add(cnt, 1u, __ATOMIC_RELAXED, __HIP_MEMORY_SCOPE_AGENT);
        const unsigned target = idx * gridDim.x;
        unsigned spins = 0;
        while (__hip_atomic_load(cnt, __ATOMIC_RELAXED, __HIP_MEMORY_SCOPE_AGENT) < target && ++spins < (1u << 26)) __builtin_amdgcn_s_sleep(1);
        __builtin_amdgcn_fence(__ATOMIC_ACQUIRE, "agent");
        asm volatile("s_waitcnt vmcnt(0)" ::: "memory");
    }
    __syncthreads();
}

__device__ __forceinline__ void tile_publish(GAS unsigned* flags, int tile, int wid) {
    asm volatile("s_waitcnt vmcnt(0)" ::: "memory");
    __syncthreads();
    if (wid == 0 && lane_id() == 0) {
        __builtin_amdgcn_fence(__ATOMIC_RELEASE, "agent");
        asm volatile("s_waitcnt vmcnt(0)" ::: "memory");
        __hip_atomic_store(flags + tile, 1u, __ATOMIC_RELAXED, __HIP_MEMORY_SCOPE_AGENT);
    }
}
__device__ __forceinline__ void tile_wait(GAS unsigned* flags, int first, int count, int wid) {
    if (wid == 0) {
        const int l = lane_id();
        for (unsigned spins = 0; spins < (1u << 24); ++spins) {
            const unsigned f0 = l < count ? __hip_atomic_load(flags + first + l, __ATOMIC_RELAXED, __HIP_MEMORY_SCOPE_AGENT) : 1u;
            const unsigned f1 = l + 64 < count ? __hip_atomic_load(flags + first + 64 + l, __ATOMIC_RELAXED, __HIP_MEMORY_SCOPE_AGENT) : 1u;
            if (__all((f0 & f1) != 0u)) break;
            __builtin_amdgcn_s_sleep(2);
        }
        __builtin_amdgcn_fence(__ATOMIC_ACQUIRE, "agent");
        asm volatile("s_waitcnt vmcnt(0)" ::: "memory");
    }
    __syncthreads();
}

__global__ void __launch_bounds__(NT) fwd_megakernel(Params pa) {
    extern __shared__ __attribute__((aligned(16))) unsigned char lds_raw[];
    LAS unsigned char* lds = (LAS unsigned char*)lds_raw;
    cg::grid_group grid = cg::this_grid();
    const int tid = threadIdx.x, lane = tid & 63, wid = __builtin_amdgcn_readfirstlane(tid >> 6);
    KP p;
#pragma unroll
    for (int i = 0; i < 27; ++i) p.in[i] = (gcfp)pa.in[i];
    p.out = (gfp)pa.out; p.ws = (gucp)pa.ws;

    phase0(p, lds, tid, lane, wid);
    const int tile = blockIdx.x;
    tile_wait((GAS unsigned*)(p.ws + WS_CTL) + 1024, 0, 24, wid);
    phaseA(p, lds, tile, 0, wid, 0);
    grid.sync();
    mixer_tile(p, lds, tile, 0, wid, 0);
    peer_tile(p, lds, 0, tile, 0, wid, 0);
    qkv_tile(p, lds, tile, 0, wid, 0);
    {
        GAS unsigned* fl = (GAS unsigned*)(p.ws + WS_CTL) + 512;
        tile_publish(fl, tile, wid);
        const int tl = tile % TILES_PER_SEQ;
        tile_wait(fl, tile - 1, tl > 0 ? 1 : 0, wid);
    }
    attn_tile(p, lds, tile, 0, wid, 0);
    oproj_tile(p, lds, tile, 0, wid, 0);
    peer_tile(p, lds, 1, tile, 0, wid, 0);
}

extern "C" void kernel_launch(void* const* d_in, const int* in_sizes, int n_in, void* d_out, int out_size, void* d_ws, size_t ws_size, hipStream_t stream) {
    static int grid_blocks = 0;
    if (grid_blocks == 0) {
        if (n_in != 27 || out_size != T * D || ws_size < WS_END) { fprintf(stderr, "kernel_launch: unexpected shapes (n_in %d out %d ws %zu)\n", n_in, out_size, ws_size); grid_blocks = -1; return; }
        int dev = 0, cus = 0, per_cu = 0;
        hipGetDevice(&dev);
        hipDeviceGetAttribute(&cus, hipDeviceAttributeMultiprocessorCount, dev);
        hipFuncSetAttribute((const void*)fwd_megakernel, hipFuncAttributeMaxDynamicSharedMemorySize, LDS_BYTES);
        hipOccupancyMaxActiveBlocksPerMultiprocessor(&per_cu, (const void*)fwd_megakernel, NT, LDS_BYTES);
        if (per_cu < 1) { fprintf(stderr, "kernel_launch: occupancy query says %d blocks per CU\n", per_cu); grid_blocks = -1; return; }
        if (cus * per_cu < NTILES) { fprintf(stderr, "kernel_launch: needs %d co-resident workgroups, the device holds %d\n", NTILES, cus * per_cu); grid_blocks = -1; return; }
        grid_blocks = NTILES;
    }
    if (grid_blocks < 0) return;
    (void)hipMemsetAsync((char*)d_ws + WS_CTL, 0, 8192, stream);
    Params p{};
    for (int i = 0; i < 27; ++i) p.in[i] = (const float*)d_in[i];
    p.out = (float*)d_out; p.ws = (unsigned char*)d_ws;
    void* args[] = {&p};
    hipError_t e = hipLaunchCooperativeKernel((const void*)fwd_megakernel, dim3(grid_blocks), dim3(NT), args, LDS_BYTES, stream);
    if (e != hipSuccess) fprintf(stderr, "cooperative launch failed: %s (grid %d)\n", hipGetErrorString(e), grid_blocks);
}
```
